# Optimizing an MI355X kernel written in HIP

```python
import math
import jax, jax.numpy as jnp
from jax import lax
import numpy as np

D_MODEL = 1024
BATCH = 8
SEQ = 4096
DEPTH = 4

N_MIXERS = 2
SB_HEADS = 16
SB_HEAD_DIM = D_MODEL // SB_HEADS
Q_BLOCK = 128
HG_EXPAND = 128
HG_HEADS = D_MODEL // HG_EXPAND
HG_KEY_DIM = HG_EXPAND
HG_VAL_DIM = D_MODEL // HG_HEADS
HG_CHUNK = 64
D_FF = 4 * D_MODEL
N_SB = (DEPTH + N_MIXERS - 1) // N_MIXERS
N_HG = DEPTH // N_MIXERS
EPS = 1e-6

kernel_name = "stick_breaking_hgrn2_hybrid"


def rmsnorm(x, gain):
    xf = x.astype(jnp.float32)
    y = xf * lax.rsqrt(jnp.mean(xf * xf, axis=-1, keepdims=True) + EPS)
    return (y * gain.astype(jnp.float32)).astype(x.dtype)


def stick_breaking_attention(q, k, v):
    seq = q.shape[2]
    scale = 1.0 / math.sqrt(q.shape[-1])
    outs = []
    for t0 in range(0, seq, Q_BLOCK):
        t1 = t0 + Q_BLOCK
        z = jnp.einsum('bhqd,bhkd->bhqk', q[:, :, t0:t1], k[:, :, :t1]).astype(jnp.float32) * scale
        causal = jnp.arange(t1)[None, :] < (t0 + jnp.arange(Q_BLOCK))[:, None]
        log_stay = jnp.where(causal, jax.nn.log_sigmoid(-z), 0.0)
        log_between = lax.cumsum(log_stay, axis=3, reverse=True) - log_stay
        weights = jnp.where(causal, jnp.exp(jax.nn.log_sigmoid(z) + log_between), 0.0)
        outs.append(jnp.einsum('bhqk,bhkd->bhqd', weights.astype(v.dtype), v[:, :, :t1]))
    return jnp.concatenate(outs, axis=2)


def stick_breaking_mixer(h, w_qkv, q_gain, k_gain, w_o):
    bsz, seq, _ = h.shape
    qkv = h @ w_qkv
    q, k, v = jnp.split(qkv, 3, axis=-1)
    q = rmsnorm(q.reshape(bsz, seq, SB_HEADS, SB_HEAD_DIM), q_gain)
    k = rmsnorm(k.reshape(bsz, seq, SB_HEADS, SB_HEAD_DIM), k_gain)
    v = v.reshape(bsz, seq, SB_HEADS, SB_HEAD_DIM)
    q, k, v = (jnp.transpose(a, (0, 2, 1, 3)) for a in (q, k, v))
    o = stick_breaking_attention(q, k, v)
    o = jnp.transpose(o, (0, 2, 1, 3)).reshape(bsz, seq, D_MODEL)
    return o @ w_o


def hgrn2_chunk_scan(q, k, v, log_f):
    bsz, nh, seq, dk = q.shape
    dv = v.shape[-1]
    n_chunks = seq // HG_CHUNK

    def to_chunks(a):
        return jnp.moveaxis(a.astype(jnp.float32).reshape(bsz, nh, n_chunks, HG_CHUNK, a.shape[-1]), 2, 0)

    incl = jnp.tril(jnp.ones((HG_CHUNK, HG_CHUNK), dtype=bool))

    def step(state, inp):
        qc, kc, vc, lfc = inp
        b = jnp.cumsum(lfc, axis=2)
        inter = jnp.einsum('bhck,bhkv->bhcv', qc * jnp.exp(b), state)
        diff = b[:, :, :, None, :] - b[:, :, None, :, :]
        decay = jnp.where(incl[:, :, None], jnp.exp(jnp.minimum(diff, 0.0)), 0.0)
        scores = jnp.einsum('bhtk,bhsk,bhtsk->bhts', qc, kc, decay)
        intra = jnp.einsum('bhts,bhsv->bhtv', scores, vc)
        b_last = b[:, :, -1:, :]
        new_state = (jnp.exp(b_last[:, :, 0, :])[..., None] * state
                     + jnp.einsum('bhsk,bhsv->bhkv', kc * jnp.exp(b_last - b), vc))
        return new_state, inter + intra

    init = jnp.zeros((bsz, nh, dk, dv), jnp.float32)
    _, ys = lax.scan(step, init, (to_chunks(q), to_chunks(k), to_chunks(v), to_chunks(log_f)))
    return jnp.moveaxis(ys, 0, 2).reshape(bsz, nh, seq, dv)


def hgrn2_mixer(h, w_in, lower_bound, norm_gain, w_o):
    bsz, seq, _ = h.shape
    proj = h @ w_in
    q, f, i, g = jnp.split(proj, 4, axis=-1)
    q = jax.nn.silu(q)
    lb = lower_bound.astype(jnp.float32)
    forget = lb + (1.0 - lb) * jax.nn.sigmoid(f.astype(jnp.float32))
    log_f = jnp.log(forget)
    k = -jnp.expm1(log_f)

    def heads(a, d):
        return jnp.transpose(a.reshape(bsz, seq, HG_HEADS, d), (0, 2, 1, 3))

    o = hgrn2_chunk_scan(heads(q, HG_KEY_DIM), heads(k, HG_KEY_DIM),
                         heads(i, HG_VAL_DIM), heads(log_f, HG_KEY_DIM))
    o = jnp.transpose(o, (0, 2, 1, 3)).astype(h.dtype)
    o = rmsnorm(o, norm_gain).reshape(bsz, seq, D_MODEL)
    o = o * jax.nn.sigmoid(g)
    return o @ w_o


def squared_relu_mlp(h, w1, w2):
    a = jax.nn.relu(h @ w1)
    return (a * a) @ w2


def setup_inputs(seed: int = 0) -> dict:
    key = jax.random.key(seed)
    ks = jax.random.split(key, 12)
    d_in = D_MODEL ** -0.5
    res = (2 * DEPTH) ** -0.5
    nrm = jax.random.normal
    return {
        "x": nrm(ks[0], (BATCH, SEQ, D_MODEL), jnp.float32),
        "norm_gains": 1.0 + 0.02 * nrm(ks[1], (DEPTH, 2, D_MODEL), jnp.float32),
        "sb_w_qkv": nrm(ks[2], (N_SB, D_MODEL, 3 * D_MODEL), jnp.float32) * d_in,
        "sb_q_gain": 1.0 + 0.02 * nrm(ks[3], (N_SB, SB_HEAD_DIM), jnp.float32),
        "sb_k_gain": 1.0 + 0.02 * nrm(ks[4], (N_SB, SB_HEAD_DIM), jnp.float32),
        "sb_w_o": nrm(ks[5], (N_SB, D_MODEL, D_MODEL), jnp.float32) * d_in * res,
        "hg_w_in": nrm(ks[6], (N_HG, D_MODEL, 4 * D_MODEL), jnp.float32) * d_in,
        "hg_lb_logits": 0.5 * nrm(ks[7], (N_HG, D_MODEL), jnp.float32),
        "hg_norm_gain": 1.0 + 0.02 * nrm(ks[8], (N_HG, HG_VAL_DIM), jnp.float32),
        "hg_w_o": nrm(ks[9], (N_HG, D_MODEL, D_MODEL), jnp.float32) * d_in * res,
        "mlp_w1": nrm(ks[10], (DEPTH, D_MODEL, D_FF), jnp.float32) * d_in,
        "mlp_w2": nrm(ks[11], (DEPTH, D_FF, D_MODEL), jnp.float32) * (D_FF ** -0.5) * res,
    }


def reference(x, norm_gains, sb_w_qkv, sb_q_gain, sb_k_gain, sb_w_o,
              hg_w_in, hg_lb_logits, hg_norm_gain, hg_w_o, mlp_w1, mlp_w2):
    p = jax.nn.softmax(hg_lb_logits.astype(jnp.float32), axis=0)
    lower_bounds = jnp.cumsum(p, axis=0) - p[0:1]
    for layer in range(DEPTH):
        j = layer // N_MIXERS
        h = rmsnorm(x, norm_gains[layer, 0])
        if layer % N_MIXERS == 0:
            x = x + stick_breaking_mixer(h, sb_w_qkv[j], sb_q_gain[j], sb_k_gain[j], sb_w_o[j])
        else:
            x = x + hgrn2_mixer(h, hg_w_in[j], lower_bounds[j], hg_norm_gain[j], hg_w_o[j])
        h = rmsnorm(x, norm_gains[layer, 1])
        x = x + squared_relu_mlp(h, mlp_w1[layer], mlp_w2[layer])
    return x
```

```cpp
#include <hip/hip_runtime.h>
#include <hip/hip_cooperative_groups.h>
#include <cstdio>
#include <cstdint>
namespace cg = cooperative_groups;
namespace pg8 {
#define PG8_LAS __attribute__((address_space(3)))
typedef unsigned short bf16_t;
typedef short bf16x8 __attribute__((ext_vector_type(8)));
typedef _Float16 f16x8 __attribute__((ext_vector_type(8)));
typedef float f32x4 __attribute__((ext_vector_type(4)));
typedef unsigned u32x4 __attribute__((ext_vector_type(4)));
constexpr int BM = 256, BK = 64, HALF = 128, HTB = HALF * BK * 2  , STAGE_BYTES = 8 * HTB, NXCD = 8, WGM = 8;

__host__ __device__ __forceinline__ int lds_byte(int r, int c) { const int st = (r >> 4) * 2 + (c >> 5), rr = r & 15, cc = c & 31, ob = rr * 64 + cc * 2; return st * 1024 + (ob ^ (((ob >> 9) & 1) << 5)); }
__host__ __device__ __forceinline__ void stage_rc(int b, int& R, int& C) { const int st = b / 1024, sb = b % 1024, swz = sb ^ (((sb >> 9) & 1) << 5); R = (st >> 1) * 16 + swz / 64; C = (st & 1) * 32 + (swz % 64) / 2; }
__host__ __device__ __forceinline__ int perm32(int rho) { const int n = rho >> 4, i = rho & 15; return 8 * (i >> 2) + 4 * n + (i & 3); }

struct Unit { int pm, pn; };
struct Gemm { const bf16_t* A; const bf16_t* Bt; int M, N, K; };

struct StaticOrder {
    int nM, nN, nwg, G, c, rev;
    __host__ __device__ void init(int M, int N, int G_, int c_, int rev_ = 0) { nM = M / BM; nN = N / BM; nwg = nM * nN; G = G_; c = c_; rev = rev_; }
    __host__ __device__ bool next(int i, Unit& u) const {
        const int nr = (nwg + G - 1) / G; if (i >= nr) return false;
        const long L = (long)(rev ? nr - 1 - i : i) * G + c; if (L >= nwg) return false;
        int wgid = (int)L; { const int q = nwg / NXCD, r = nwg % NXCD, xcd = wgid % NXCD, off = wgid / NXCD; wgid = (xcd < r ? xcd * (q + 1) : r * (q + 1) + (xcd - r) * q) + off; }
        const int nig = WGM * nN, gid = wgid / nig, fm = gid * WGM, gsz = (nM - fm) < WGM ? (nM - fm) : WGM;
        u.pm = fm + ((wgid % nig) % gsz); u.pn = (wgid % nig) / gsz; return true;
    }
    __device__ __forceinline__ void a_ready(const Unit&) const {}
    __device__ __forceinline__ void done(const Unit&) const {}
};


__device__ __forceinline__ unsigned cvt_pk_bf16(float lo, float hi) { unsigned r; asm volatile("v_cvt_pk_bf16_f32 %0, %1, %2" : "=v"(r) : "v"(lo), "v"(hi)); return r; }
constexpr float RMS_EPS = 1e-6f;
constexpr float QSCALE = 0.125f * 1.4426950408889634f;

struct EpiQKV {
    static constexpr bool PERM = true, AFTER_DRAIN = false, NEEDS_RS = true;
    bf16_t* Q; size_t plane; const float* rowss; const float* qg; long kdelta;
    __device__ __forceinline__ void operator()(const f32x4 (&acc)[2][2][4][2], const Unit& u, int wr, int wc, int fr, int fq, const PG8_LAS float* rst) const {
        const int sec = u.pn >> 2, head = 4 * (u.pn & 3) + wc;
        bf16_t* base = Q + (size_t)sec * plane;
        const float* gp = qg + (sec == 1 ? kdelta : 0);
        const float osc = sec == 0 ? QSCALE : 1.0f;
        f32x4 g[2][2];
#pragma unroll
        for (int bj = 0; bj < 2; ++bj)
#pragma unroll
            for (int n = 0; n < 2; ++n) g[bj][n] = *(const f32x4*)(gp + 32 * bj + 8 * fq + 4 * n);
#pragma unroll
        for (int ai = 0; ai < 2; ++ai)
#pragma unroll
            for (int m = 0; m < 4; ++m) {
                const int row = u.pm * BM + ai * HALF + wr * 64 + m * 16 + fr;
                const float rstd = rst[ai * HALF + wr * 64 + m * 16 + fr];
                f32x4 v[2][2]; float ss = 0.f;
#pragma unroll
                for (int bj = 0; bj < 2; ++bj)
#pragma unroll
                    for (int n = 0; n < 2; ++n) { v[bj][n] = acc[ai][bj][m][n] * rstd; const f32x4 t = v[bj][n]; ss += (t[0] * t[0] + t[1] * t[1]) + (t[2] * t[2] + t[3] * t[3]); }
                if (sec < 2) {
                    { auto s16 = __builtin_amdgcn_permlane16_swap(__float_as_uint(ss), __float_as_uint(ss), false, false);
                      ss = __uint_as_float(s16[0]) + __uint_as_float(s16[1]);
                      auto s32 = __builtin_amdgcn_permlane32_swap(__float_as_uint(ss), __float_as_uint(ss), false, false);
                      ss = __uint_as_float(s32[0]) + __uint_as_float(s32[1]); }
                    const float r = __builtin_amdgcn_rsqf(ss * (1.0f / 64.0f) + RMS_EPS) * osc;
#pragma unroll
                    for (int bj = 0; bj < 2; ++bj)
#pragma unroll
                        for (int n = 0; n < 2; ++n) v[bj][n] = v[bj][n] * r * g[bj][n];
                }
                bf16_t* rowp = base + (size_t)row * 1024 + head * 64 + 8 * fq;
#pragma unroll
                for (int bj = 0; bj < 2; ++bj) { u32x4 w; w.x = cvt_pk_bf16(v[bj][0][0], v[bj][0][1]); w.y = cvt_pk_bf16(v[bj][0][2], v[bj][0][3]); w.z = cvt_pk_bf16(v[bj][1][0], v[bj][1][1]); w.w = cvt_pk_bf16(v[bj][1][2], v[bj][1][3]);
                    *(u32x4*)(rowp + 32 * bj) = w; }
            }
    }
};

__device__ __forceinline__ unsigned short f2h(float f) { _Float16 h = (_Float16)f; return __builtin_bit_cast(unsigned short, h); }
__device__ __forceinline__ float h2f(unsigned short u) { return (float)__builtin_bit_cast(_Float16, u); }
typedef _Float16 h2v_t __attribute__((ext_vector_type(2))); typedef float f2v_t __attribute__((ext_vector_type(2)));
__device__ __forceinline__ unsigned pk_h2(float lo, float hi) { const f2v_t v = {lo, hi}; const h2v_t h = __builtin_convertvector(v, h2v_t); return __builtin_bit_cast(unsigned, h); }

struct EpiHgIn {
    static constexpr bool PERM = true, AFTER_DRAIN = false, NEEDS_RS = true;
    bf16_t* Qh; size_t plane; const float* rowss; const float* lbl; int jl;
    __device__ __forceinline__ void operator()(const f32x4 (&acc)[2][2][4][2], const Unit& u, int wr, int wc, int fr, int fq, const PG8_LAS float* rst) const {
        const int sec = u.pn >> 2;
        bf16_t* base = Qh + (size_t)sec * plane;
        const int col0 = (u.pn & 3) * BM + wc * 32 + 8 * fq;
        f32x4 lb[2][2];
#pragma unroll
        for (int bj = 0; bj < 2; ++bj)
#pragma unroll
            for (int n = 0; n < 2; ++n) { lb[bj][n] = (f32x4){0.f, 0.f, 0.f, 0.f};
                if (sec == 1 && jl == 1) { const f32x4 l0 = *(const f32x4*)(lbl + col0 + bj * HALF + 4 * n), l1 = *(const f32x4*)(lbl + 1024 + col0 + bj * HALF + 4 * n);
#pragma unroll
                    for (int e = 0; e < 4; ++e) lb[bj][n][e] = __builtin_amdgcn_rcpf(1.0f + __expf(l0[e] - l1[e])); } }
#pragma unroll
        for (int ai = 0; ai < 2; ++ai)
#pragma unroll
            for (int m = 0; m < 4; ++m) {
                const int row = u.pm * BM + ai * HALF + wr * 64 + m * 16 + fr;
                const float rstd = rst[ai * HALF + wr * 64 + m * 16 + fr];
                bf16_t* rowp = base + (size_t)row * 1024 + col0;
#pragma unroll
                for (int bj = 0; bj < 2; ++bj) {
                    float v[8];
#pragma unroll
                    for (int e = 0; e < 8; ++e) v[e] = acc[ai][bj][m][e >> 2][e & 3] * rstd;
                    u32x4 w;
                    if (sec == 1) {
#pragma unroll
                        for (int e = 0; e < 8; ++e) { const float l = lb[bj][e >> 2][e & 3]; const float sg = __builtin_amdgcn_rcpf(1.0f + __expf(-v[e]));     v[e] = __builtin_amdgcn_logf(l + (1.0f - l) * sg); }
                        w.x = pk_h2(v[0], v[1]); w.y = pk_h2(v[2], v[3]); w.z = pk_h2(v[4], v[5]); w.w = pk_h2(v[6], v[7]);
                    } else {
                        if (sec == 0) {
#pragma unroll
                            for (int e = 0; e < 8; ++e) v[e] = v[e] * __builtin_amdgcn_rcpf(1.0f + __expf(-v[e]));
                        } else if (sec == 3) {
#pragma unroll
                            for (int e = 0; e < 8; ++e) v[e] = __builtin_amdgcn_rcpf(1.0f + __expf(-v[e]));
                        }
                        w.x = cvt_pk_bf16(v[0], v[1]); w.y = cvt_pk_bf16(v[2], v[3]); w.z = cvt_pk_bf16(v[4], v[5]); w.w = cvt_pk_bf16(v[6], v[7]);
                    }
                    *(u32x4*)(rowp + bj * HALF) = w;
                }
            }
    }
};

template <bool FINAL> struct EpiRes {
    static constexpr bool PERM = true, AFTER_DRAIN = false, NEEDS_RS = false;
    bf16_t* xh; float* rowss_out; float* out32;
    __device__ __forceinline__ void operator()(const f32x4 (&acc)[2][2][4][2], const Unit& u, int wr, int wc, int fr, int fq) const {
        const int col0 = u.pn * BM + wc * 32 + 8 * fq;
        u32x4 xin[8][2];
#define PG8_RES_LOAD(g) do { _Pragma("unroll") for (int bj = 0; bj < 2; ++bj) xin[g][bj] = *(const u32x4*)(xh + (size_t)(u.pm * BM + ((g) >> 2) * HALF + wr * 64 + ((g) & 3) * 16 + fr) * 1024 + col0 + bj * HALF); } while (0)
#pragma unroll
        for (int g = 0; g < 6; ++g) PG8_RES_LOAD(g);
        asm volatile("" ::: "memory");
#pragma unroll
        for (int g = 0; g < 8; ++g) {
            const int ai = g >> 2, m = g & 3;
            const int row = u.pm * BM + ai * HALF + wr * 64 + m * 16 + fr;
            const size_t off = (size_t)row * 1024 + col0; float ss = 0.f;
#pragma unroll
            for (int bj = 0; bj < 2; ++bj) {
                const u32x4 xw = xin[g][bj];
                const f32x4 x0 = {h2f((unsigned short)(xw.x & 0xffffu)), h2f((unsigned short)(xw.x >> 16)), h2f((unsigned short)(xw.y & 0xffffu)), h2f((unsigned short)(xw.y >> 16))};
                const f32x4 x1 = {h2f((unsigned short)(xw.z & 0xffffu)), h2f((unsigned short)(xw.z >> 16)), h2f((unsigned short)(xw.w & 0xffffu)), h2f((unsigned short)(xw.w >> 16))};
                const f32x4 v0 = x0 + acc[ai][bj][m][0], v1 = x1 + acc[ai][bj][m][1];
                if (FINAL) { *(f32x4*)(out32 + off + bj * HALF) = v0; *(f32x4*)(out32 + off + bj * HALF + 4) = v1; }
                else {
                    u32x4 hw; hw.x = pk_h2(v0[0], v0[1]); hw.y = pk_h2(v0[2], v0[3]); hw.z = pk_h2(v1[0], v1[1]); hw.w = pk_h2(v1[2], v1[3]);
                    *(u32x4*)(xh + off + bj * HALF) = hw;
                    ss += (v0[0] * v0[0] + v0[1] * v0[1]) + (v0[2] * v0[2] + v0[3] * v0[3]) + (v1[0] * v1[0] + v1[1] * v1[1]) + (v1[2] * v1[2] + v1[3] * v1[3]);
                }
            }
            if (!FINAL) { ss += __shfl_xor(ss, 16); ss += __shfl_xor(ss, 32); if (fq == 0) atomicAdd(rowss_out + row, ss); }
            if (g + 6 < 8) PG8_RES_LOAD(g + 6);
            asm volatile("" ::: "memory");
        }
#undef PG8_RES_LOAD
    }
};

struct EpiUp {
    static constexpr bool PERM = true, AFTER_DRAIN = false, NEEDS_RS = true;
    bf16_t* H; const float* rowss;
    __device__ __forceinline__ void operator()(const f32x4 (&acc)[2][2][4][2], const Unit& u, int wr, int wc, int fr, int fq, const PG8_LAS float* rst) const {
        const int col0 = u.pn * BM + wc * 32 + 8 * fq;
#pragma unroll
        for (int ai = 0; ai < 2; ++ai)
#pragma unroll
            for (int m = 0; m < 4; ++m) {
                const int row = u.pm * BM + ai * HALF + wr * 64 + m * 16 + fr;
                const float rstd = rst[ai * HALF + wr * 64 + m * 16 + fr];
                bf16_t* rowp = H + (size_t)row * 4096 + col0;
#pragma unroll
                for (int bj = 0; bj < 2; ++bj) {
                    float v[8];
#pragma unroll
                    for (int e = 0; e < 8; ++e) { const float t = fmaxf(acc[ai][bj][m][e >> 2][e & 3] * rstd, 0.f); v[e] = t * t; }
                    u32x4 w; w.x = cvt_pk_bf16(v[0], v[1]); w.y = cvt_pk_bf16(v[2], v[3]); w.z = cvt_pk_bf16(v[4], v[5]); w.w = cvt_pk_bf16(v[6], v[7]);
                    *(u32x4*)(rowp + bj * HALF) = w;
                }
            }
    }
};

template <class Epi, class Sched, bool ALIGN_EPI = false, bool SP2 = false, bool F16 = false>
__device__ __forceinline__ void gemm_phase(PG8_LAS unsigned char* lds, const Gemm g, const Sched& S, const Epi& E) {
    int tid_ = threadIdx.x; asm volatile("" : "+v"(tid_));
    const int tid = tid_, wid = __builtin_amdgcn_readfirstlane(tid >> 6), lane = tid & 63, wr = wid >> 2, wc = wid & 3, fr = lane & 15, fq = lane >> 4;
    const int K = g.K, nt = K / BK;
    unsigned voffA[2], voffB[2];
#pragma unroll
    for (int i = 0; i < 2; ++i) { int R, C; stage_rc(tid * 16 + i * 8192, R, C); const int Rb = Epi::PERM ? ((R & ~31) + perm32(R & 31)) : R;
        voffA[i] = (unsigned)(R * K + C) * 2u; voffB[i] = (unsigned)(Rb * K + C) * 2u; }
    const size_t kstep = (size_t)(BK * 2);
    const size_t hstep = (size_t)HALF * K * 2;
    const size_t tstep = 2 * hstep;
    const unsigned ldsw = (unsigned)wid * 1024u;
    const int aoff = lds_byte(wr * 64 + fr, fq * 8), boff = lds_byte(wc * 32 + fr, fq * 8);
#define PG8_SA(b, h) (((b) * 2 + (h)) * HTB)
#define PG8_SB(b, h) ((4 + (b) * 2 + (h)) * HTB)
#define PG8_STAGE(bufoff, gbase, voff) do { _Pragma("unroll") for (int _i = 0; _i < 2; ++_i) \
        __builtin_amdgcn_global_load_lds((const unsigned*)((const char*)(gbase) + (voff)[_i]), (PG8_LAS unsigned*)(lds + (bufoff) + ldsw + _i * 8192), 16, 0, 0); } while (0)
#define PG8_LDA(dst, b, h) do { _Pragma("unroll") for (int m = 0; m < 4; ++m) _Pragma("unroll") for (int k = 0; k < 2; ++k) dst[m][k] = *(const PG8_LAS bf16x8*)(lds + PG8_SA(b, h) + aoff + m * 2048 + k * 1024); } while (0)
#define PG8_LDB(dst, b, h) do { _Pragma("unroll") for (int n = 0; n < 2; ++n) _Pragma("unroll") for (int k = 0; k < 2; ++k) dst[n][k] = *(const PG8_LAS bf16x8*)(lds + PG8_SB(b, h) + boff + n * 2048 + k * 1024); } while (0)
#define PG8_MMA(ai, bj, At, Bt) do { __builtin_amdgcn_s_setprio(1); _Pragma("unroll") for (int m = 0; m < 4; ++m) _Pragma("unroll") for (int n = 0; n < 2; ++n) _Pragma("unroll") for (int k = 0; k < 2; ++k) \
        acc[ai][bj][m][n] = F16 ? __builtin_amdgcn_mfma_f32_16x16x32_f16(__builtin_bit_cast(f16x8, Bt[n][k]), __builtin_bit_cast(f16x8, At[m][k]), acc[ai][bj][m][n], 0, 0, 0) \
                                : __builtin_amdgcn_mfma_f32_16x16x32_bf16(Bt[n][k], At[m][k], acc[ai][bj][m][n], 0, 0, 0); __builtin_amdgcn_s_setprio(0); } while (0)
#define PG8_WAIT_V(n) asm volatile("s_waitcnt vmcnt(" #n ")" ::: "memory")
#define PG8_WAIT_L(n) asm volatile("s_waitcnt lgkmcnt(" #n ")" ::: "memory")
#define PG8_BAR __builtin_amdgcn_s_barrier()
#define PG8_SCHED __builtin_amdgcn_sched_barrier(0)
    Unit cur, nxt; int ui = 0;
    if (!S.next(0, cur)) return;
    f32x4 acc[2][2][4][2];
#pragma unroll
    for (int a = 0; a < 2; ++a)
#pragma unroll
        for (int b = 0; b < 2; ++b)
#pragma unroll
            for (int m = 0; m < 4; ++m)
#pragma unroll
                for (int n = 0; n < 2; ++n) acc[a][b][m][n] = (f32x4){0.f, 0.f, 0.f, 0.f};
    bf16x8 At[4][2], B0[2][2], B1[2][2];
    const char* cA = (const char*)g.A + (size_t)cur.pm * tstep; const char* cB = (const char*)g.Bt + (size_t)cur.pn * tstep;
    S.a_ready(cur);
    float rs_pref = 0.f;
    if constexpr (Epi::NEEDS_RS) { if (tid < 256) rs_pref = E.rowss[cur.pm * BM + tid]; }
    if constexpr (SP2) {
        PG8_STAGE(PG8_SB(0, 0), cB, voffB); PG8_STAGE(PG8_SB(0, 1), cB + hstep, voffB); PG8_STAGE(PG8_SA(0, 0), cA, voffA); PG8_STAGE(PG8_SA(0, 1), cA + hstep, voffA);
        if (wr == 1) PG8_BAR;
        PG8_WAIT_V(2); PG8_BAR;
        PG8_STAGE(PG8_SB(1, 0), cB + kstep, voffB); PG8_STAGE(PG8_SA(1, 0), cA + kstep, voffA); PG8_STAGE(PG8_SB(1, 1), cB + hstep + kstep, voffB);
        PG8_WAIT_V(6); PG8_BAR;
    } else {
        PG8_STAGE(PG8_SB(0, 0), cB, voffB); PG8_STAGE(PG8_SA(0, 0), cA, voffA); PG8_STAGE(PG8_SB(0, 1), cB + hstep, voffB); PG8_STAGE(PG8_SA(0, 1), cA + hstep, voffA);
        if (wr == 1) PG8_BAR;
        PG8_WAIT_V(4); PG8_BAR;
        PG8_STAGE(PG8_SB(1, 0), cB + kstep, voffB); PG8_STAGE(PG8_SA(1, 0), cA + kstep, voffA); PG8_STAGE(PG8_SB(1, 1), cB + hstep + kstep, voffB);
        PG8_WAIT_V(6); PG8_BAR;
    }
    for (;;) {
        const bool has_next = S.next(ui + 1, nxt);
        const char* nA = has_next ? (const char*)g.A + (size_t)nxt.pm * tstep : cA; const char* nB = has_next ? (const char*)g.Bt + (size_t)nxt.pn * tstep : cB;
        for (int t = 0; t < nt; t += 2) {
            const bool last = (t == nt - 2);
            const char* a1 = cA + (size_t)(t + 1) * kstep;
            const char* a2 = last ? nA : cA + (size_t)(t + 2) * kstep; const char* b2 = last ? nB : cB + (size_t)(t + 2) * kstep;
            const char* a3 = a2 + kstep; const char* b3 = b2 + kstep;
            if (last && has_next) S.a_ready(nxt);
            if constexpr (SP2) {
            PG8_LDB(B0, 0, 0); PG8_LDB(B1, 0, 1); PG8_SCHED; PG8_LDA(At, 0, 0); PG8_STAGE(PG8_SA(1, 1), a1 + hstep, voffA);
            PG8_WAIT_V(8); PG8_WAIT_L(0); PG8_BAR; PG8_MMA(0, 0, At, B0); PG8_MMA(0, 1, At, B1); PG8_BAR; PG8_SCHED;
            PG8_LDA(At, 0, 1); PG8_STAGE(PG8_SB(0, 0), b2, voffB); PG8_STAGE(PG8_SB(0, 1), b2 + hstep, voffB); PG8_STAGE(PG8_SA(0, 0), a2, voffA);
            PG8_WAIT_V(8); PG8_WAIT_L(0); PG8_BAR; PG8_MMA(1, 0, At, B0); PG8_MMA(1, 1, At, B1); PG8_BAR; PG8_SCHED;
            PG8_LDB(B0, 1, 0); PG8_LDB(B1, 1, 1); PG8_SCHED; PG8_LDA(At, 1, 0); PG8_STAGE(PG8_SA(0, 1), a2 + hstep, voffA);
            PG8_WAIT_V(8); PG8_WAIT_L(0); PG8_BAR; PG8_MMA(0, 0, At, B0); PG8_MMA(0, 1, At, B1); PG8_BAR; PG8_SCHED;
            PG8_LDA(At, 1, 1); PG8_STAGE(PG8_SB(1, 0), b3, voffB); PG8_STAGE(PG8_SB(1, 1), b3 + hstep, voffB); PG8_STAGE(PG8_SA(1, 0), a3, voffA);
            PG8_WAIT_V(8); PG8_WAIT_L(0); PG8_BAR; PG8_MMA(1, 0, At, B0); PG8_MMA(1, 1, At, B1); PG8_BAR; PG8_SCHED;
            } else {
            PG8_LDB(B0, 0, 0); PG8_SCHED; PG8_LDA(At, 0, 0); PG8_STAGE(PG8_SA(1, 1), a1 + hstep, voffA);
            PG8_WAIT_L(8); PG8_BAR; PG8_WAIT_L(0); PG8_MMA(0, 0, At, B0); PG8_BAR; PG8_SCHED;
            PG8_LDB(B1, 0, 1); PG8_STAGE(PG8_SB(0, 0), b2, voffB);
            PG8_BAR; PG8_WAIT_L(0); PG8_MMA(0, 1, At, B1); PG8_BAR;
            PG8_LDA(At, 0, 1); PG8_STAGE(PG8_SA(0, 0), a2, voffA);
            PG8_BAR; PG8_WAIT_L(0); PG8_MMA(1, 0, At, B0); PG8_BAR; PG8_SCHED;
            PG8_STAGE(PG8_SB(0, 1), b2 + hstep, voffB);
            PG8_WAIT_V(6); PG8_BAR; PG8_MMA(1, 1, At, B1); PG8_BAR;
            PG8_LDB(B0, 1, 0); PG8_SCHED; PG8_LDA(At, 1, 0); PG8_STAGE(PG8_SA(0, 1), a2 + hstep, voffA);
            PG8_WAIT_L(8); PG8_BAR; PG8_WAIT_L(0); PG8_MMA(0, 0, At, B0); PG8_BAR; PG8_SCHED;
            PG8_LDB(B1, 1, 1); PG8_STAGE(PG8_SB(1, 0), b3, voffB);
            PG8_BAR; PG8_WAIT_L(0); PG8_MMA(0, 1, At, B1); PG8_BAR;
            PG8_LDA(At, 1, 1); PG8_STAGE(PG8_SA(1, 0), a3, voffA);
            PG8_BAR; PG8_WAIT_L(0); PG8_MMA(1, 0, At, B0); PG8_BAR; PG8_SCHED;
            PG8_STAGE(PG8_SB(1, 1), b3 + hstep, voffB);
            PG8_WAIT_V(6); PG8_BAR; PG8_MMA(1, 1, At, B1); PG8_BAR;
            }
        }
        if constexpr (ALIGN_EPI) { if (wr == 0) PG8_BAR; }
        if constexpr (!Epi::AFTER_DRAIN) {
            if constexpr (Epi::NEEDS_RS) {
                static_assert(ALIGN_EPI, "the row-statistics table needs both half-workgroups in the epilogue at the same time");
                if (tid < 256) *(PG8_LAS float*)(lds + STAGE_BYTES + 256 + tid * 4) = __builtin_amdgcn_rsqf(rs_pref * (1.0f / 1024.0f) + RMS_EPS);
                asm volatile("s_waitcnt lgkmcnt(0)\n\ts_barrier" ::: "memory");
                if (has_next && tid < 256) rs_pref = E.rowss[nxt.pm * BM + tid];
                E(acc, cur, wr, wc, fr, fq, (const PG8_LAS float*)(lds + STAGE_BYTES + 256));
            } else E(acc, cur, wr, wc, fr, fq);
            S.done(cur); }
        if (!has_next) break;
#pragma unroll
        for (int a = 0; a < 2; ++a)
#pragma unroll
            for (int b = 0; b < 2; ++b)
#pragma unroll
                for (int m = 0; m < 4; ++m)
#pragma unroll
                    for (int n = 0; n < 2; ++n) acc[a][b][m][n] = (f32x4){0.f, 0.f, 0.f, 0.f};
        cur = nxt; cA = nA; cB = nB; ++ui;
        if constexpr (ALIGN_EPI) { if (wr == 1) PG8_BAR; }
    }
    PG8_WAIT_V(0);
    if constexpr (!ALIGN_EPI) { if (wr == 0) PG8_BAR; }
    PG8_BAR;
    if constexpr (Epi::AFTER_DRAIN) { E.fused(acc, cur, wr, wc, fr, fq, lds, wid, lane); S.done(cur); }
#undef PG8_SA
#undef PG8_SB
#undef PG8_STAGE
#undef PG8_LDA
#undef PG8_LDB
#undef PG8_MMA
#undef PG8_WAIT_V
#undef PG8_WAIT_L
#undef PG8_BAR
#undef PG8_SCHED
}
}

#define LAS __attribute__((address_space(3)))
typedef unsigned short bf16;
typedef short bf16x8 __attribute__((ext_vector_type(8)));
typedef short s16x4 __attribute__((ext_vector_type(4)));
typedef float f32x4 __attribute__((ext_vector_type(4)));
typedef float f32x16 __attribute__((ext_vector_type(16)));
typedef unsigned u32x4 __attribute__((ext_vector_type(4)));
typedef unsigned u32x2 __attribute__((ext_vector_type(2)));
typedef float f32x2_t __attribute__((ext_vector_type(2)));
typedef __bf16 bf16x2_t __attribute__((ext_vector_type(2)));
#define MFMA32(a, b, c) __builtin_amdgcn_mfma_f32_32x32x16_bf16((a), (b), (c), 0, 0, 0)
__device__ __forceinline__ unsigned cvtpk(float lo, float hi) { f32x2_t v = {lo, hi}; bf16x2_t b = __builtin_convertvector(v, bf16x2_t); return __builtin_bit_cast(unsigned, b); }
__device__ __forceinline__ unsigned short f2bf1(float f) { return (unsigned short)(cvtpk(f, 0.f) & 0xffffu); }
__device__ __forceinline__ float bf2f(unsigned short u) { return __uint_as_float((unsigned)u << 16); }
__device__ __forceinline__ int crow(int r, int hi) { return (r & 3) + 8 * (r >> 2) + 4 * hi; }
__device__ __forceinline__ float ex2(float x) { return __builtin_amdgcn_exp2f(x); }
__device__ __forceinline__ float lg2(float x) { return __builtin_amdgcn_logf(x); }
__device__ __forceinline__ float fmul_s(float a, float b) { float r = a * b; asm("" : "+v"(r)); return r; }
__device__ __forceinline__ float fadd1_s(float a) { return 1.0f + a; }
typedef short v4i16_t __attribute__((ext_vector_type(4)));
__device__ __forceinline__ s16x4 vtr(const LAS unsigned char* p) { return __builtin_bit_cast(s16x4, __builtin_amdgcn_ds_read_tr16_b64_v4i16((LAS v4i16_t*)p)); }

#define XB_TMO      128
#define XB_XCNT(j)  (256  + 64 * (j))
#define XB_XSUB(j)  (1280 + 64 * (j))
#define XB_XGEN(j)  (2304 + 64 * (j))
#define XB_TOP      3328
#define XB_TOPGEN   3392
#define XCD_BAR_WORDS 3456
#define XB_SPIN_CAP (1u << 18)

__device__ __forceinline__ unsigned xb_ld(unsigned* p)              { return __hip_atomic_load(p, __ATOMIC_RELAXED, __HIP_MEMORY_SCOPE_AGENT); }
__device__ __forceinline__ unsigned xb_add(unsigned* p, unsigned v) { return __hip_atomic_fetch_add(p, v, __ATOMIC_RELAXED, __HIP_MEMORY_SCOPE_AGENT); }
__device__ __forceinline__ unsigned xb_xcc_id() { return (unsigned)__builtin_amdgcn_s_getreg((3 << 11) | 20) & 0xFu; }
#define XB_SPIN(cond, bar) do { unsigned _sp = 0; while (cond) { __builtin_amdgcn_s_sleep(1); \
    if ((++_sp & 255u) == 0u) { if (xb_ld(&(bar)[XB_TMO])) break; if (_sp > XB_SPIN_CAP) { atomicAdd(&(bar)[XB_TMO], 1u); break; } } } } while (0)

struct XcdBarrier {
    unsigned* bar; unsigned x;
    volatile LAS unsigned* st;
};

__device__ __forceinline__ XcdBarrier xcd_barrier_post(unsigned* bar, volatile LAS unsigned* st) {
    XcdBarrier b; b.bar = bar; b.x = xb_xcc_id(); b.st = st;
    if (threadIdx.x == 0) (void)xb_add(&bar[XB_XCNT(b.x)], 1u);
    return b;
}
__device__ __forceinline__ void xcd_barrier_complete(unsigned* bar, unsigned x, unsigned& nloc, unsigned& nx) {
    const unsigned G = gridDim.x * gridDim.y * gridDim.z;
    unsigned sum, cnt, mine, sp = 0u;
    for (;;) {
        sum = 0u; cnt = 0u; mine = 0u;
#pragma unroll
        for (unsigned j = 0; j < 16; ++j) { const unsigned c = xb_ld(&bar[XB_XCNT(j)]); sum += c; cnt += (c > 0u) ? 1u : 0u; mine = (j == x) ? c : mine; }
        if (sum == G) break;
        __builtin_amdgcn_s_sleep(1);
        if ((++sp & 255u) == 0u) { if (xb_ld(&bar[XB_TMO])) break; if (sp > XB_SPIN_CAP) { atomicAdd(&bar[XB_TMO], 1u); break; } }
    }
    nloc = mine > 0u ? mine : 1u; nx = cnt > 0u ? cnt : 1u;
}

__device__ __forceinline__ void xcd_barrier(const XcdBarrier& b) {
    asm volatile("s_waitcnt vmcnt(0)" ::: "memory");
    __syncthreads();
    if (threadIdx.x == 0) {
        unsigned* bar = b.bar;
        __builtin_amdgcn_s_waitcnt(0);
        unsigned nloc = b.st[0], nx = b.st[1];
        if (nloc == 0u) { xcd_barrier_complete(bar, b.x, nloc, nx); b.st[0] = nloc; b.st[1] = nx; }
        const unsigned old = xb_add(&bar[XB_XSUB(b.x)], 1u);
        const unsigned gen = old / nloc;
        if (old + 1u == (gen + 1u) * nloc) {
            __builtin_amdgcn_fence(__ATOMIC_RELEASE, "agent");
            asm volatile("s_waitcnt vmcnt(0)" ::: "memory");
            const unsigned og = xb_add(&bar[XB_TOP], 1u);
            const unsigned tg = og / nx;
            if (og + 1u == (tg + 1u) * nx) xb_add(&bar[XB_TOPGEN], 1u);
            else XB_SPIN(xb_ld(&bar[XB_TOPGEN]) == tg, bar);
            __builtin_amdgcn_fence(__ATOMIC_ACQUIRE, "agent");
            xb_add(&bar[XB_XGEN(b.x)], 1u);
            asm volatile("s_waitcnt vmcnt(0)" ::: "memory");
        } else {
            XB_SPIN(xb_ld(&bar[XB_XGEN(b.x)]) == gen, bar);
            __builtin_amdgcn_fence(__ATOMIC_ACQUIRE, "agent");
            asm volatile("s_waitcnt vmcnt(0)" ::: "memory");
        }
    }
    __syncthreads();
}

constexpr int BATCH = 8, SEQ = 4096, DM = 1024, FF = 4096, MTOK = BATCH * SEQ, DEPTH = 4;

namespace sba {
constexpr int KSTR = 144, TROWS = 128, TILE_B = TROWS * KSTR;
constexpr int LDS_K = 0, LDS_V = 2 * TILE_B, LDS_FLG = 4 * TILE_B, LDS_BYTES = LDS_FLG + 64;

template <bool MASK>
__device__ __forceinline__ void block32(const LAS unsigned char* Kb, const LAS unsigned char* Vb, int kb, const bf16x8 (&qr)[4], f32x16 (&o)[2], float& R, int lim, int r32, int hi, int lane) {
    f32x16 p = {};
    const LAS unsigned char* kp = Kb + (32 * kb + r32) * KSTR + hi * 16;
#pragma unroll
    for (int s = 0; s < 4; ++s) { const bf16x8 kf = *(const LAS bf16x8*)(kp + s * 32); p = MFMA32(kf, qr[s], p); }
    float e[16], u[16];
#pragma unroll
    for (int i = 0; i < 16; ++i) { float v = ex2(p[i]); if (MASK) v = ((i & 3) + 8 * (i >> 2) < lim) ? v : 0.f; e[i] = v; u[i] = fadd1_s(v); }
    float pab[4], pabc[4], rG[4], tm[4], om1[4];
#pragma unroll
    for (int m = 0; m < 4; ++m) {
        pab[m] = fmul_s(u[4 * m], u[4 * m + 1]); pabc[m] = fmul_s(pab[m], u[4 * m + 2]); rG[m] = __builtin_amdgcn_rcpf(fmul_s(pabc[m], u[4 * m + 3]));
        const unsigned own = __float_as_uint(rG[m]);
        auto sw = __builtin_amdgcn_permlane32_swap(own, own, false, false);
        tm[m] = fmul_s(__uint_as_float(sw[0]), __uint_as_float(sw[1]));
        om1[m] = (hi == 0) ? __uint_as_float(sw[1]) : 1.0f;
    }
    float T[4]; T[3] = 1.0f; T[2] = tm[3]; T[1] = fmul_s(tm[3], tm[2]); T[0] = fmul_s(T[1], tm[1]);
    float w[16];
#pragma unroll
    for (int m = 0; m < 4; ++m) {
        const float base = fmul_s(fmul_s(R, T[m]), fmul_s(om1[m], rG[m]));
        w[4 * m] = fmul_s(e[4 * m], base); w[4 * m + 1] = fmul_s(e[4 * m + 1], fmul_s(base, u[4 * m])); w[4 * m + 2] = fmul_s(e[4 * m + 2], fmul_s(base, pab[m])); w[4 * m + 3] = fmul_s(e[4 * m + 3], fmul_s(base, pabc[m]));
    }
    R = fmul_s(R, fmul_s(T[0], tm[0]));
    const int q4 = (lane & 15) >> 2, pp = lane & 3, blk = (lane >> 4) & 1;
#pragma unroll
    for (int s = 0; s < 2; ++s) {
        u32x4 pk; pk.x = cvtpk(w[8 * s], w[8 * s + 1]); pk.y = cvtpk(w[8 * s + 2], w[8 * s + 3]); pk.z = cvtpk(w[8 * s + 4], w[8 * s + 5]); pk.w = cvtpk(w[8 * s + 6], w[8 * s + 7]);
        const bf16x8 pb = __builtin_bit_cast(bf16x8, pk);
#pragma unroll
        for (int db = 0; db < 2; ++db) {
            const LAS unsigned char* vp = Vb + (32 * kb + 16 * s + 4 * hi + q4) * KSTR + (32 * db + 16 * blk) * 2 + 8 * pp;
            const s16x4 lo = vtr(vp), hh = vtr(vp + 8 * KSTR);
            const bf16x8 va = __builtin_shufflevector(lo, hh, 0, 1, 2, 3, 4, 5, 6, 7);
            o[db] = MFMA32(va, pb, o[db]);
        }
    }
}

__device__ __forceinline__ void unit(const bf16* Q, const bf16* K, const bf16* V, bf16* O, int b, int h, int qb, LAS unsigned char* lds) {
    int tid_ = threadIdx.x; asm volatile("" : "+v"(tid_));
    const int tid = tid_, lane = tid & 63, r32 = lane & 31, hi = lane >> 5; const int wid = __builtin_amdgcn_readfirstlane(tid >> 6);
    const size_t rowbase = (size_t)b * SEQ; const int q0 = qb * 256;
    const int qabs = q0 + 32 * wid + r32;
    const bf16* Qw = Q + (rowbase + qabs) * DM + h * 64;
    bf16x8 qr[4];
#pragma unroll
    for (int s = 0; s < 4; ++s) qr[s] = *(const bf16x8*)(Qw + 16 * s + 8 * hi);
    const int srow = tid >> 3, sch = tid & 7;
    const bf16* Ks = K + (rowbase + srow) * DM + h * 64 + sch * 8;
    const bf16* Vs = V + (rowbase + srow) * DM + h * 64 + sch * 8;
    const int sdst = srow * KSTR + sch * 16;
    const int NT = (q0 + 256) / TROWS;
    f32x16 o[2]; o[0] = f32x16{}; o[1] = f32x16{};
    float R = 1.0f;
    __syncthreads();
    { const size_t g0 = (size_t)(NT - 1) * TROWS * DM;
      const u32x4 k0 = *(const u32x4*)(Ks + g0), k1 = *(const u32x4*)(Ks + g0 + 64 * DM), v0 = *(const u32x4*)(Vs + g0), v1 = *(const u32x4*)(Vs + g0 + 64 * DM);
      *(LAS u32x4*)(lds + LDS_K + sdst) = k0; *(LAS u32x4*)(lds + LDS_K + sdst + 64 * KSTR) = k1; *(LAS u32x4*)(lds + LDS_V + sdst) = v0; *(LAS u32x4*)(lds + LDS_V + sdst + 64 * KSTR) = v1; }
    __syncthreads();
    const int qmin = q0 + 32 * wid, qmax = qmin + 31;
    bool wdone = false;
    LAS unsigned* flg = (LAS unsigned*)(lds + LDS_FLG);
    int it = 0;
    for (int t = NT - 1; t >= 0; --t, ++it) {
        const int cur = (NT - 1 - t) & 1;
        u32x4 kn0 = {}, kn1 = {}, vn0 = {}, vn1 = {};
        if (t > 0) { const size_t g0 = (size_t)(t - 1) * TROWS * DM; kn0 = *(const u32x4*)(Ks + g0); kn1 = *(const u32x4*)(Ks + g0 + 64 * DM); vn0 = *(const u32x4*)(Vs + g0); vn1 = *(const u32x4*)(Vs + g0 + 64 * DM); }
        const LAS unsigned char* Kb = lds + LDS_K + cur * TILE_B; const LAS unsigned char* Vb = lds + LDS_V + cur * TILE_B;
        if (!wdone) {
            if (TROWS * t + TROWS - 1 < qmin) {
#pragma unroll 1
                for (int kbi = 0; kbi < 4; kbi += 2) {
                    block32<false>(Kb, Vb, 3 - kbi, qr, o, R, 0, r32, hi, lane); block32<false>(Kb, Vb, 2 - kbi, qr, o, R, 0, r32, hi, lane);
                    wdone = (__ballot(R == 0.0f) == ~0ull); if (wdone) break;
                }
            } else {
#pragma unroll 1
                for (int kbi = 0; kbi < 4; ++kbi) {
                    const int kb = 3 - kbi, kv0 = TROWS * t + 32 * kb;
                    if (kv0 < qmax) {
                        if (kv0 + 31 < qmin) block32<false>(Kb, Vb, kb, qr, o, R, 0, r32, hi, lane);
                        else block32<true>(Kb, Vb, kb, qr, o, R, qabs - kv0 - 4 * hi, r32, hi, lane);
                        wdone = (__ballot(R == 0.0f) == ~0ull); if (wdone) break;
                    }
                }
            }
        }
        if (t > 0) { LAS unsigned char* kd = lds + LDS_K + (cur ^ 1) * TILE_B + sdst; LAS unsigned char* vd = lds + LDS_V + (cur ^ 1) * TILE_B + sdst;
            *(LAS u32x4*)kd = kn0; *(LAS u32x4*)(kd + 64 * KSTR) = kn1; *(LAS u32x4*)vd = vn0; *(LAS u32x4*)(vd + 64 * KSTR) = vn1; }
        if (lane == 0) flg[(it & 1) * 8 + wid] = wdone ? 1u : 0u;
        __syncthreads();
        const u32x4 f0 = *(const LAS u32x4*)(flg + (it & 1) * 8), f1 = *(const LAS u32x4*)(flg + (it & 1) * 8 + 4);
        if ((f0.x & f0.y & f0.z & f0.w & f1.x & f1.y & f1.z & f1.w) != 0u) break;
    }
    bf16* Ow = O + (rowbase + qabs) * DM + h * 64;
#pragma unroll
    for (int db = 0; db < 2; ++db)
#pragma unroll
        for (int g = 0; g < 4; ++g) { u32x2 w; w.x = cvtpk(o[db][4 * g], o[db][4 * g + 1]); w.y = cvtpk(o[db][4 * g + 2], o[db][4 * g + 3]);
            *(u32x2*)(Ow + 32 * db + 8 * g + 4 * hi) = w; }
}

__device__ __forceinline__ void phase(const bf16* Q, const bf16* K, const bf16* V, bf16* O, LAS unsigned char* lds, int vcu, int G) {
    for (int pi = vcu; pi < BATCH * 16 * 8; pi += G) {
        const int bh = pi >> 3, sx = pi & 7;
        unit(Q, K, V, O, bh >> 4, bh & 15, 15 - sx, lds);
        unit(Q, K, V, O, bh >> 4, bh & 15, sx, lds);
    }
}
}

namespace hgs {
#define HGS_BAR() asm volatile("s_waitcnt lgkmcnt(0)\n\ts_barrier" ::: "memory")
constexpr int RS = 272, RS2 = 144;
typedef float f32x2v __attribute__((ext_vector_type(2)));
constexpr int P_QD = 0, P_KD = 64 * RS, P_SEG = 2 * 64 * RS, P_BYTES = P_SEG + 8 * 128 * 4;

__device__ __forceinline__ void pre_phase(bf16* Qh, bf16* LF, bf16* SCG, float* CT, LAS unsigned char* lds, int vcu, int G) {
    int tid_ = threadIdx.x; asm volatile("" : "+v"(tid_));
    const int tid = tid_, lane = tid & 63, r32 = lane & 31, hi = lane >> 5; const int wid = __builtin_amdgcn_readfirstlane(tid >> 6);
    const int kp = lane, seg = wid;
    constexpr int NITEM = BATCH * 8 * (SEQ / 64);
#define PRE_CI(s_) ((((s_) & (NITEM / 2 - 1)) >> 5) * 64 + (((s_) & 31) + ((s_) < NITEM / 2 ? 32 : 0)))
    __syncthreads();
    unsigned nq[8], nf[8];
    int it = vcu;
    if (it < NITEM) { const int ci0 = PRE_CI(it), bh = ci0 >> 6, cc = ci0 & 63; const size_t o0 = ((size_t)(bh >> 3) * SEQ + cc * 64 + 8 * seg) * DM + (bh & 7) * 128 + 2 * kp;
#pragma unroll
        for (int j = 0; j < 8; ++j) { nq[j] = *(const unsigned*)(Qh + o0 + (size_t)j * DM); nf[j] = *(const unsigned*)(LF + o0 + (size_t)j * DM); } }
    for (; it < NITEM; it += G) {
        const int ci = PRE_CI(it), bh = ci >> 6, cc = ci & 63; const size_t o0 = ((size_t)(bh >> 3) * SEQ + cc * 64 + 8 * seg) * DM + (bh & 7) * 128 + 2 * kp;
        float q0[8], q1[8], b0[8], b1[8], k0[8], k1[8];
        float run0 = 0.f, run1 = 0.f;
#pragma unroll
        for (int j = 0; j < 8; ++j) {
            q0[j] = __uint_as_float(nq[j] << 16); q1[j] = __uint_as_float(nq[j] & 0xffff0000u);
            const float l0 = pg8::h2f((unsigned short)(nf[j] & 0xffffu)), l1 = pg8::h2f((unsigned short)(nf[j] >> 16));
            k0[j] = 1.0f - ex2(l0); k1[j] = 1.0f - ex2(l1); run0 += l0; run1 += l1; b0[j] = run0; b1[j] = run1;
        }
        if (it + G < NITEM) { const int it2 = PRE_CI(it + G), bh2 = it2 >> 6, cc2 = it2 & 63; const size_t o2 = ((size_t)(bh2 >> 3) * SEQ + cc2 * 64 + 8 * seg) * DM + (bh2 & 7) * 128 + 2 * kp;
#pragma unroll
            for (int j = 0; j < 8; ++j) { nq[j] = *(const unsigned*)(Qh + o2 + (size_t)j * DM); nf[j] = *(const unsigned*)(LF + o2 + (size_t)j * DM); } }
        *(LAS f32x2v*)(lds + P_SEG + (seg * 128 + 2 * kp) * 4) = (f32x2v){run0, run1};
        HGS_BAR();
        {
            float off0 = 0.f, off1 = 0.f, br0 = 0.f, br1 = 0.f, tot0 = 0.f, tot1 = 0.f;
#pragma unroll
            for (int s = 0; s < 8; ++s) { const f32x2v v = *(const LAS f32x2v*)(lds + P_SEG + (s * 128 + 2 * kp) * 4);
                if (s == 4) { br0 = tot0; br1 = tot1; }
                if (s == seg) { off0 = tot0; off1 = tot1; }
                tot0 += v.x; tot1 += v.y; }
            if (seg == 0) { float* ct = CT + (size_t)ci * 384 + 2 * kp;
                *(f32x2v*)(ct) = (f32x2v){ex2(br0), ex2(br1)}; *(f32x2v*)(ct + 128) = (f32x2v){ex2(tot0 - br0), ex2(tot1 - br1)}; *(f32x2v*)(ct + 256) = (f32x2v){ex2(tot0), ex2(tot1)}; }
            off0 -= br0; off1 -= br1;
#pragma unroll
            for (int j = 0; j < 8; ++j) {
                const float d0 = off0 + b0[j], d1 = off1 + b1[j];
                const unsigned qd = cvtpk(q0[j] * ex2(d0), q1[j] * ex2(d1)), kd = cvtpk(k0[j] * ex2(-d0), k1[j] * ex2(-d1));
                const int t = 8 * seg + j;
                *(LAS unsigned*)(lds + P_QD + t * RS + 4 * kp) = qd; *(LAS unsigned*)(lds + P_KD + t * RS + 4 * kp) = kd;
                *(unsigned*)(Qh + o0 + (size_t)j * DM) = qd; *(unsigned*)(LF + o0 + (size_t)j * DM) = kd;
            }
        }
        HGS_BAR();
        if (wid < 3) {
            const int tb = wid == 0 ? 0 : 1, sb = wid == 2 ? 1 : 0;
            f32x16 a = {};
            const LAS unsigned char* ap = lds + P_QD + (32 * tb + r32) * RS + hi * 16;
            const LAS unsigned char* bp = lds + P_KD + (32 * sb + r32) * RS + hi * 16;
#pragma unroll
            for (int s = 0; s < 8; ++s) a = MFMA32(*(const LAS bf16x8*)(ap + s * 32), *(const LAS bf16x8*)(bp + s * 32), a);
            bf16* sg = SCG + (size_t)ci * 4096 + 32 * sb + r32;
#pragma unroll
            for (int i = 0; i < 16; ++i) { const int t = 32 * tb + crow(i, hi), s_ = 32 * sb + r32; sg[t * 64] = f2bf1((s_ <= t) ? a[i] : 0.f); }
        }
        HGS_BAR();
    }
}

constexpr int S_QD = 0, S_KD = 64 * RS, S_SC = 2 * 64 * RS, S_VT = S_SC + 64 * RS2, S_CT = S_VT + 32 * RS2, S_BUF = S_CT + 1536, S_ST = 2 * S_BUF, S_YB = S_ST + 32 * RS, S_CTS = S_YB + 2 * 4096, S_ST2 = S_CTS + 3 * 1536, LDS_BYTES = S_ST2 + 32 * RS;
static_assert(S_BUF % 16 == 0 && LDS_BYTES <= 131072, "hgs scan LDS map");

struct Pref { u32x4 q0, q1, k0, k1, s; f32x4 c; u32x2 v; };
struct Ctx { const bf16* qsrc; const bf16* ksrc; const bf16* ssrc; const float* csrc; const bf16* vsrc; bf16* ydst; int qdst, sdst, vs, vv, tid, lane, r32, hi, wid, q4, pp, blk; };

__device__ __forceinline__ void fetch(Pref& P, const Ctx& X, int c) {
    const size_t a = (size_t)c * 64 * DM;
    P.q0 = *(const u32x4*)(X.qsrc + a); P.q1 = *(const u32x4*)(X.qsrc + a + 32 * DM); P.k0 = *(const u32x4*)(X.ksrc + a); P.k1 = *(const u32x4*)(X.ksrc + a + 32 * DM);
    P.s = *(const u32x4*)(X.ssrc + (size_t)c * 4096); P.c = *(const f32x4*)(X.csrc + (size_t)(c + 1 < SEQ / 64 ? c + 1 : SEQ / 64 - 1) * 384);     P.v = *(const u32x2*)(X.vsrc + a);
}

__device__ __forceinline__ void chunk(Pref& P, const Ctx& X, int c, int m3, LAS unsigned char* lds, f32x16& st) {
    const int tid = X.tid, r32 = X.r32, hi = X.hi, wid = X.wid;
    LAS unsigned char* bufp = lds + (c & 1) * S_BUF;
    *(LAS u32x4*)(bufp + S_QD + X.qdst) = P.q0; *(LAS u32x4*)(bufp + S_QD + X.qdst + 32 * RS) = P.q1;
    *(LAS u32x4*)(bufp + S_KD + X.qdst) = P.k0; *(LAS u32x4*)(bufp + S_KD + X.qdst + 32 * RS) = P.k1;
    *(LAS u32x4*)(bufp + S_SC + X.sdst) = P.s;
    *(LAS f32x4*)(lds + S_CTS + ((m3 + 1) % 3) * 1536 + (tid < 96 ? tid : 95) * 16) = P.c;
    *(LAS unsigned short*)(bufp + S_VT + (X.vv + 0) * RS2 + X.vs * 2) = (unsigned short)(P.v.x & 0xffffu);
    *(LAS unsigned short*)(bufp + S_VT + (X.vv + 1) * RS2 + X.vs * 2) = (unsigned short)(P.v.x >> 16);
    *(LAS unsigned short*)(bufp + S_VT + (X.vv + 2) * RS2 + X.vs * 2) = (unsigned short)(P.v.y & 0xffffu);
    *(LAS unsigned short*)(bufp + S_VT + (X.vv + 3) * RS2 + X.vs * 2) = (unsigned short)(P.v.y >> 16);
    fetch(P, X, c + 3 < SEQ / 64 ? c + 3 : SEQ / 64 - 1);
    HGS_BAR();
    { const int cp = c > 0 ? c - 1 : 0;
      *(u32x2*)(X.ydst + (size_t)cp * 64 * DM) = *(const LAS u32x2*)(lds + S_YB + (cp & 1) * 4096 + tid * 8); }
    LAS unsigned char* st_rd = lds + ((c & 1) ? S_ST2 : S_ST);
    LAS unsigned char* st_wr = lds + ((c & 1) ? S_ST : S_ST2);
    if (wid >= 4) {
        const int kb4 = wid - 4;
        const LAS float* ct = (const LAS float*)(lds + S_CTS + m3 * 1536); const LAS float* cs = ct + 128; const LAS float* dec = ct + 256;
        const LAS float* cin = (const LAS float*)(lds + S_CTS + ((m3 + 1) % 3) * 1536);
        f32x16 d = {};
        const LAS unsigned char* ap = bufp + S_KD + (8 * hi + X.q4) * RS + (32 * kb4 + 16 * X.blk) * 2 + 8 * X.pp;
        const LAS unsigned char* bp = bufp + S_VT + r32 * RS2 + hi * 16;
#pragma unroll
        for (int s = 0; s < 4; ++s) { const s16x4 lo = vtr(ap + 16 * s * RS), hh = vtr(ap + (16 * s + 4) * RS);
            d = MFMA32(__builtin_shufflevector(lo, hh, 0, 1, 2, 3, 4, 5, 6, 7), *(const LAS bf16x8*)(bp + s * 32), d); }
#pragma unroll
        for (int g = 0; g < 4; ++g) { const f32x4 d4 = *(const LAS f32x4*)(dec + 32 * kb4 + 8 * g + 4 * hi), s4 = *(const LAS f32x4*)(cs + 32 * kb4 + 8 * g + 4 * hi), c4 = *(const LAS f32x4*)(cin + 32 * kb4 + 8 * g + 4 * hi);
#pragma unroll
            for (int e = 0; e < 4; ++e) st[4 * g + e] = st[4 * g + e] * d4[e] + d[4 * g + e] * s4[e];
            u32x2 w; w.x = cvtpk(st[4 * g] * c4[0], st[4 * g + 1] * c4[1]); w.y = cvtpk(st[4 * g + 2] * c4[2], st[4 * g + 3] * c4[3]);
            *(LAS u32x2*)(st_wr + r32 * RS + (32 * kb4 + 8 * g + 4 * hi) * 2) = w; }
    } else if (wid < 2) {
        const int tb = wid;
        f32x16 a = {};
        const LAS unsigned char* ap = bufp + S_QD + (32 * tb + r32) * RS + hi * 16;
        const LAS unsigned char* bp = st_rd + r32 * RS + hi * 16;
#pragma unroll
        for (int s = 0; s < 8; ++s) a = MFMA32(*(const LAS bf16x8*)(ap + s * 32), *(const LAS bf16x8*)(bp + s * 32), a);
        const LAS unsigned char* cp = bufp + S_SC + (32 * tb + r32) * RS2 + hi * 16;
        const LAS unsigned char* vp = bufp + S_VT + r32 * RS2 + hi * 16;
#pragma unroll
        for (int s = 0; s < 4; ++s) if (s < 2 || tb == 1) a = MFMA32(*(const LAS bf16x8*)(cp + s * 32), *(const LAS bf16x8*)(vp + s * 32), a);
        LAS unsigned char* yb = lds + S_YB + (c & 1) * 4096 + (32 * tb) * 64 + r32 * 2;
#pragma unroll
        for (int i = 0; i < 16; ++i) *(LAS unsigned short*)(yb + crow(i, hi) * 64) = f2bf1(a[i]);
    }
}

__device__ __forceinline__ void item(const bf16* QD, const bf16* KD, const bf16* Iv, const bf16* SCG, const float* CT, bf16* Y, int b, int h, int vq, LAS unsigned char* lds) {
    int tid_ = threadIdx.x; asm volatile("" : "+v"(tid_));
    Ctx X;
    X.tid = tid_; X.lane = X.tid & 63; X.r32 = X.lane & 31; X.hi = X.lane >> 5; X.wid = __builtin_amdgcn_readfirstlane(X.tid >> 6);
    const int tid = X.tid;
    const size_t tokb = (size_t)b * SEQ;
    X.qsrc = QD + (tokb + (tid >> 4)) * DM + h * 128 + (tid & 15) * 8;
    X.ksrc = KD + (tokb + (tid >> 4)) * DM + h * 128 + (tid & 15) * 8;
    X.qdst = (tid >> 4) * RS + (tid & 15) * 16;
    X.ssrc = SCG + (size_t)((b * 8 + h) * 64) * 4096 + (tid >> 3) * 64 + (tid & 7) * 8;
    X.sdst = (tid >> 3) * RS2 + (tid & 7) * 16;
    X.csrc = CT + (size_t)((b * 8 + h) * 64) * 384 + (tid < 96 ? tid : 95) * 4;
    X.vs = tid >> 3; X.vv = (tid & 7) * 4;
    X.vsrc = Iv + (tokb + X.vs) * DM + h * 128 + vq * 32 + X.vv;
    X.ydst = Y + (tokb + (tid >> 3)) * DM + h * 128 + vq * 32 + (tid & 7) * 4;
    X.q4 = (X.lane & 15) >> 2; X.pp = X.lane & 3; X.blk = (X.lane >> 4) & 1;
    f32x16 st = {};
    __syncthreads();
    Pref p0, p1, p2;
    { const f32x4 c0 = *(const f32x4*)(X.csrc); *(LAS f32x4*)(lds + S_CTS + (tid < 96 ? tid : 95) * 16) = c0; }
    for (int i = tid; i < 32 * RS / 4; i += 512) ((LAS unsigned*)(lds + S_ST))[i] = 0u;
    fetch(p0, X, 0); fetch(p1, X, 1); fetch(p2, X, 2);
    static_assert((SEQ / 64) % 3 == 1, "chunk loop: 21 x 3 + 1");
    for (int c = 0; c + 1 < SEQ / 64; c += 3) { chunk(p0, X, c, 0, lds, st); chunk(p1, X, c + 1, 1, lds, st); chunk(p2, X, c + 2, 2, lds, st); }
    chunk(p0, X, SEQ / 64 - 1, 0, lds, st);
    HGS_BAR();
    *(u32x2*)(X.ydst + (size_t)(SEQ / 64 - 1) * 64 * DM) = *(const LAS u32x2*)(lds + S_YB + ((SEQ / 64 - 1) & 1) * 4096 + tid * 8);
}

__device__ __forceinline__ void phase(const bf16* QD, const bf16* KD, const bf16* Iv, const bf16* SCG, const float* CT, bf16* Y, LAS unsigned char* lds, int vcu, int G) {
    for (int it = vcu; it < BATCH * 8 * 4; it += G) { const int bh = it >> 2; item(QD, KD, Iv, SCG, CT, Y, bh >> 3, bh & 7, it & 3, lds); }
}

__device__ __forceinline__ void norm_phase(const bf16* Y, const bf16* G, const float* gain, bf16* O, int gw, int ngw, int lane_) {
    int lane = lane_; asm volatile("" : "+v"(lane));
    float gn[16];
#pragma unroll
    for (int e = 0; e < 16; ++e) gn[e] = gain[(lane & 7) * 16 + e];
    for (int row = gw; row < MTOK; row += ngw) {
        const size_t off = (size_t)row * DM + lane * 16;
        const u32x4 y0 = *(const u32x4*)(Y + off), y1 = *(const u32x4*)(Y + off + 8), g0 = *(const u32x4*)(G + off), g1 = *(const u32x4*)(G + off + 8);
        const unsigned yw[8] = {y0.x, y0.y, y0.z, y0.w, y1.x, y1.y, y1.z, y1.w}, gw_[8] = {g0.x, g0.y, g0.z, g0.w, g1.x, g1.y, g1.z, g1.w};
        float yv[16], gv[16]; float ss = 0.f;
#pragma unroll
        for (int e = 0; e < 8; ++e) { yv[2 * e] = __uint_as_float(yw[e] << 16); yv[2 * e + 1] = __uint_as_float(yw[e] & 0xffff0000u); gv[2 * e] = __uint_as_float(gw_[e] << 16); gv[2 * e + 1] = __uint_as_float(gw_[e] & 0xffff0000u); }
#pragma unroll
        for (int e = 0; e < 16; ++e) ss += yv[e] * yv[e];
        ss += __shfl_xor(ss, 1); ss += __shfl_xor(ss, 2); ss += __shfl_xor(ss, 4);
        const float r = __builtin_amdgcn_rsqf(ss * (1.0f / 128.0f) + 1e-6f);
        unsigned ow[8];
#pragma unroll
        for (int e = 0; e < 8; ++e) ow[e] = cvtpk(yv[2 * e] * r * gn[2 * e] * gv[2 * e], yv[2 * e + 1] * r * gn[2 * e + 1] * gv[2 * e + 1]);
        *(u32x4*)(O + off) = (u32x4){ow[0], ow[1], ow[2], ow[3]}; *(u32x4*)(O + off + 8) = (u32x4){ow[4], ow[5], ow[6], ow[7]};
    }
}
}

constexpr size_t MiB = 1u << 20;
constexpr size_t WS_ROWSS = 0;
constexpr size_t WS_BAR = 1536 * 1024;
constexpr size_t WS_W = 2 * MiB;
constexpr size_t W_SBQKV = WS_W, W_SBO = W_SBQKV + 2 * 6 * MiB, W_HGIN = W_SBO + 2 * 2 * MiB, W_HGO = W_HGIN + 2 * 8 * MiB, W_W1 = W_HGO + 2 * 2 * MiB, W_W2 = W_W1 + 4 * 8 * MiB;
constexpr size_t WS_XB = 104 * MiB;
constexpr size_t WS_BIG = 168 * MiB;
constexpr size_t WS_XH = WS_BIG + 256 * MiB;
constexpr size_t WS_END = WS_XH + 64 * MiB;
static_assert(W_W2 + 4 * 8 * MiB <= WS_XB, "weights fit");
constexpr int LDS_BYTES = 135168;

template <bool QKVPERM, bool F16OUT>
__device__ __forceinline__ void transpose_item(const float* W, int K, int N, const float* gain, bf16* WT, LAS float* scr, int item, int lane) {
    const int nblk = N / 32, kb = item / nblk, nb = item % nblk, k0 = 64 * kb, n0 = 32 * nb;
#pragma unroll 8
    for (int i = 0; i < 8; ++i) { const int kk = 8 * i + (lane >> 3); const float gk = gain ? gain[k0 + kk] : 1.0f;
        const f32x4 v = *(const f32x4*)(W + (size_t)(k0 + kk) * N + n0 + (lane & 7) * 4); LAS float* d = scr + kk * 33 + (lane & 7) * 4; d[0] = v[0] * gk; d[1] = v[1] * gk; d[2] = v[2] * gk; d[3] = v[3] * gk; }
    asm volatile("s_waitcnt lgkmcnt(0)" ::: "memory");
    int r0 = n0;
    if (QKVPERM) { const int sec = n0 >> 10, nn = n0 & 1023, pnl = nn >> 8, wc = (nn & 255) >> 6, bj = (nn & 63) >> 5; r0 = sec * 1024 + pnl * 256 + bj * 128 + wc * 32; }
    const int c = lane & 7;
#pragma unroll
    for (int j = 0; j < 4; ++j) { const int n = (lane >> 3) + 8 * j; const LAS float* s = scr + (8 * c) * 33 + n;
        u32x4 o;
        if (F16OUT) { o.x = pg8::pk_h2(s[0 * 33], s[1 * 33]); o.y = pg8::pk_h2(s[2 * 33], s[3 * 33]); o.z = pg8::pk_h2(s[4 * 33], s[5 * 33]); o.w = pg8::pk_h2(s[6 * 33], s[7 * 33]); }
        else { o.x = cvtpk(s[0 * 33], s[1 * 33]); o.y = cvtpk(s[2 * 33], s[3 * 33]); o.z = cvtpk(s[4 * 33], s[5 * 33]); o.w = cvtpk(s[6 * 33], s[7 * 33]); }
        *(u32x4*)(WT + (size_t)(r0 + n) * K + k0 + 8 * c) = o; }
    asm volatile("s_waitcnt lgkmcnt(0)" ::: "memory");
}

struct Args { const float* in[12]; float* out; unsigned char* ws; };

__global__ void __launch_bounds__(512, 2) trunk_fwd(Args args) {
    extern __shared__ __attribute__((aligned(16))) unsigned char lds_raw[];
    cg::grid_group grid = cg::this_grid();
    LAS unsigned char* lds = (LAS unsigned char*)lds_raw;
    const int tid = threadIdx.x, lane = tid & 63, wave = __builtin_amdgcn_readfirstlane(tid >> 6);
    const int G = gridDim.x, bx = blockIdx.x, vcu = (G % 8 == 0) ? (bx % 8) * (G / 8) + bx / 8 : bx;
    const int gw = vcu * 8 + wave, NGW = G * 8;
    volatile LAS unsigned* MISC = (volatile LAS unsigned*)(lds + 131072);
    if (tid < 32) MISC[tid] = 0u;
    __syncthreads();
    unsigned char* ws = args.ws;
    const float* x = args.in[0]; const float* norm_gains = args.in[1]; const float* sb_w_qkv = args.in[2]; const float* sb_q_gain = args.in[3]; const float* sb_k_gain = args.in[4];
    const float* sb_w_o = args.in[5]; const float* hg_w_in = args.in[6]; const float* hg_lb = args.in[7]; const float* hg_norm_gain = args.in[8]; const float* hg_w_o = args.in[9];
    const float* mlp_w1 = args.in[10]; const float* mlp_w2 = args.in[11];
    float* out = args.out;
    float* rowss = (float*)(ws + WS_ROWSS);
    bf16* XB = (bf16*)(ws + WS_XB);
    bf16* XH = (bf16*)(ws + WS_XH);
    bf16* BIG = (bf16*)(ws + WS_BIG);
    const size_t PLANE = (size_t)MTOK * DM;

    {
        LAS float* scr = (LAS float*)(lds + wave * 16384);
        constexpr int I_QKV = (DM / 64) * (3 * DM / 32), I_O = (DM / 64) * (DM / 32), I_IN = (DM / 64) * (4 * DM / 32), I_1 = (DM / 64) * (FF / 32), I_2 = (FF / 64) * (DM / 32);
        constexpr int NITEMS = 2 * I_QKV + 2 * I_O + 2 * I_IN + 2 * I_O + 4 * I_1 + 4 * I_2;
        for (int it = gw; it < NITEMS; it += NGW) {
            int r = it;
            if (r < 2 * I_QKV) { const int j = r / I_QKV; transpose_item<true, true>(sb_w_qkv + (size_t)j * DM * 3 * DM, DM, 3 * DM, norm_gains + (size_t)(2 * (2 * j)) * DM, (bf16*)(ws + W_SBQKV) + (size_t)j * 3 * DM * DM, scr, r % I_QKV, lane); continue; } r -= 2 * I_QKV;
            if (r < 2 * I_O) { const int j = r / I_O; transpose_item<false, false>(sb_w_o + (size_t)j * DM * DM, DM, DM, nullptr, (bf16*)(ws + W_SBO) + (size_t)j * DM * DM, scr, r % I_O, lane); continue; } r -= 2 * I_O;
            if (r < 2 * I_IN) { const int j = r / I_IN; transpose_item<false, true>(hg_w_in + (size_t)j * DM * 4 * DM, DM, 4 * DM, norm_gains + (size_t)(2 * (2 * j + 1)) * DM, (bf16*)(ws + W_HGIN) + (size_t)j * 4 * DM * DM, scr, r % I_IN, lane); continue; } r -= 2 * I_IN;
            if (r < 2 * I_O) { const int j = r / I_O; transpose_item<false, false>(hg_w_o + (size_t)j * DM * DM, DM, DM, nullptr, (bf16*)(ws + W_HGO) + (size_t)j * DM * DM, scr, r % I_O, lane); continue; } r -= 2 * I_O;
            if (r < 4 * I_1) { const int l = r / I_1; transpose_item<false, true>(mlp_w1 + (size_t)l * DM * FF, DM, FF, norm_gains + (size_t)(2 * l + 1) * DM, (bf16*)(ws + W_W1) + (size_t)l * FF * DM, scr, r % I_1, lane); continue; } r -= 4 * I_1;
            { const int l = r / I_2; transpose_item<false, false>(mlp_w2 + (size_t)l * FF * DM, FF, DM, nullptr, (bf16*)(ws + W_W2) + (size_t)l * DM * FF, scr, r % I_2, lane); }
        }
        for (int m = gw; m < MTOK; m += NGW) {
            const f32x4* xr = (const f32x4*)(x + (size_t)m * DM) + lane; float s = 0.f;
            unsigned long long* h8 = (unsigned long long*)(XH + (size_t)m * DM) + lane;
#pragma unroll
            for (int j = 0; j < 4; ++j) { const f32x4 v = xr[64 * j]; s += (v[0] * v[0] + v[1] * v[1]) + (v[2] * v[2] + v[3] * v[3]); h8[64 * j] = (unsigned long long)pg8::pk_h2(v[0], v[1]) | ((unsigned long long)pg8::pk_h2(v[2], v[3]) << 32); }
#pragma unroll
            for (int o = 1; o < 64; o <<= 1) s += __shfl_xor(s, o);
            if (lane == 0) rowss[m] = s;
        }
        for (int i = bx * 512 + tid; i < 8 * MTOK; i += G * 512) rowss[MTOK + i] = 0.f;
        if (bx == 0) for (int i = tid; i < XCD_BAR_WORDS; i += 512) ((unsigned*)(ws + WS_BAR))[i] = 0u;
    }
    grid.sync();
    const XcdBarrier xbar = xcd_barrier_post((unsigned*)(ws + WS_BAR), MISC + 8);
#define SEAM() xcd_barrier(xbar)

    for (int L = 0; L < DEPTH; ++L) {
        const int j = L >> 1;
        const bf16* mixA;
        const bf16* mixW;
        if ((L & 1) == 0) {
            bf16* Qb = BIG; bf16* Kb = BIG + PLANE; bf16* Vb = BIG + 2 * PLANE;
            { pg8::Gemm g{XH, (const bf16*)(ws + W_SBQKV) + (size_t)j * 3 * DM * DM, MTOK, 3 * DM, DM}; pg8::StaticOrder S; S.init(MTOK, 3 * DM, G, bx);
              pg8::EpiQKV E{Qb, PLANE, rowss + (size_t)(2 * L) * MTOK, sb_q_gain + j * 64, (long)(sb_k_gain - sb_q_gain)};
              pg8::gemm_phase<pg8::EpiQKV, pg8::StaticOrder, true, true, true>(lds, g, S, E);
 }
            SEAM();
            sba::phase(Qb, Kb, Vb, Qb, lds, vcu, G);
            mixA = Qb; mixW = (const bf16*)(ws + W_SBO) + (size_t)j * DM * DM;
        } else {
            bf16* Qh = BIG; bf16* LF = BIG + PLANE; bf16* Iv = BIG + 2 * PLANE; bf16* Gg = BIG + 3 * PLANE;
            { pg8::Gemm g{XH, (const bf16*)(ws + W_HGIN) + (size_t)j * 4 * DM * DM, MTOK, 4 * DM, DM}; pg8::StaticOrder S; S.init(MTOK, 4 * DM, G, bx);
              pg8::EpiHgIn E{Qh, PLANE, rowss + (size_t)(2 * L) * MTOK, hg_lb, j};
              pg8::gemm_phase<pg8::EpiHgIn, pg8::StaticOrder, true, true, true>(lds, g, S, E);
 }
            SEAM();
            bf16* SCG = (bf16*)out; float* CT = (float*)((unsigned char*)out + 32 * MiB);
            hgs::pre_phase(Qh, LF, SCG, CT, lds, vcu, G);
            SEAM();
            hgs::phase(Qh, LF, Iv, SCG, CT, XB, lds, vcu, G);
            SEAM();
            hgs::norm_phase(XB, Gg, hg_norm_gain + j * 128, Qh, gw, NGW, lane);
            mixA = Qh; mixW = (const bf16*)(ws + W_HGO) + (size_t)j * DM * DM;
        }
        SEAM();
        { pg8::Gemm g{mixA, mixW, MTOK, DM, DM}; pg8::StaticOrder S; S.init(MTOK, DM, G, bx);
          pg8::EpiRes<false> E{XH, rowss + (size_t)(2 * L + 1) * MTOK, nullptr};
          pg8::gemm_phase<pg8::EpiRes<false>, pg8::StaticOrder, true, true>(lds, g, S, E);
 }
        SEAM();
        { pg8::Gemm g{XH, (const bf16*)(ws + W_W1) + (size_t)L * FF * DM, MTOK, FF, DM}; pg8::StaticOrder S; S.init(MTOK, FF, G, bx);
          pg8::EpiUp E{BIG, rowss + (size_t)(2 * L + 1) * MTOK};
          pg8::gemm_phase<pg8::EpiUp, pg8::StaticOrder, true, true, true>(lds, g, S, E);
 }
        SEAM();
        { pg8::Gemm g{BIG, (const bf16*)(ws + W_W2) + (size_t)L * DM * FF, MTOK, DM, FF}; pg8::StaticOrder S; S.init(MTOK, DM, G, bx, 1);
          if (L + 1 < DEPTH) { pg8::EpiRes<false> E{XH, rowss + (size_t)(2 * L + 2) * MTOK, nullptr}; pg8::gemm_phase<pg8::EpiRes<false>, pg8::StaticOrder, true, true>(lds, g, S, E); }
          else { pg8::EpiRes<true> E{XH, nullptr, out}; pg8::gemm_phase<pg8::EpiRes<true>, pg8::StaticOrder, true, true>(lds, g, S, E); }
 }
        if (L + 1 < DEPTH) SEAM();
    }
}

extern "C" void kernel_launch(void* const* d_in, const int* in_sizes, int n_in, void* d_out, int out_size, void* d_ws, size_t ws_size, hipStream_t stream) {
    static int grid = 0;
    if (grid == 0) {
        if (n_in != 12 || in_sizes[0] != MTOK * DM || out_size != MTOK * DM || ws_size < WS_END) { fprintf(stderr, "kernel_launch: unexpected shapes / workspace (n_in %d, ws %zu, need %zu)\n", n_in, ws_size, (size_t)WS_END); grid = -1; return; }
        int dev = 0, cus = 0, per_cu = 0;
        hipGetDevice(&dev); hipDeviceGetAttribute(&cus, hipDeviceAttributeMultiprocessorCount, dev);
        if (hipFuncSetAttribute((const void*)trunk_fwd, hipFuncAttributeMaxDynamicSharedMemorySize, LDS_BYTES) != hipSuccess) { fprintf(stderr, "kernel_launch: hipFuncSetAttribute failed\n"); grid = -1; return; }
        if (hipOccupancyMaxActiveBlocksPerMultiprocessor(&per_cu, (const void*)trunk_fwd, 512, LDS_BYTES) != hipSuccess || per_cu < 1) { fprintf(stderr, "kernel_launch: occupancy query says %d\n", per_cu); per_cu = 1; }
        (void)hipGetLastError();
        grid = cus * per_cu;
    }
    if (grid < 0) return;
    Args a{};
    for (int i = 0; i < 12; ++i) a.in[i] = (const float*)d_in[i];
    a.out = (float*)d_out; a.ws = (unsigned char*)d_ws;
    void* kargs[] = {&a};
    hipError_t e = hipLaunchCooperativeKernel((const void*)trunk_fwd, dim3(grid), dim3(512), kargs, LDS_BYTES, stream);
    if (e != hipSuccess) fprintf(stderr, "cooperative launch failed: %s (grid %d)\n", hipGetErrorString(e), grid);
}
```

```cpp
#include <hip/hip_runtime.h>
#include <hip/hip_cooperative_groups.h>
#include <cstdio>
#include <cstdint>
namespace cg = cooperative_groups;
namespace pg8 {
#define PG8_LAS __attribute__((address_space(3)))
typedef unsigned short bf16_t;
typedef short bf16x8 __attribute__((ext_vector_type(8)));
typedef _Float16 f16x8 __attribute__((ext_vector_type(8)));
typedef float f32x4 __attribute__((ext_vector_type(4)));
typedef unsigned u32x4 __attribute__((ext_vector_type(4)));
constexpr int BM = 256, BK = 64, HALF = 128, HTB = HALF * BK * 2  , STAGE_BYTES = 8 * HTB, NXCD = 8, WGM = 8;

__host__ __device__ __forceinline__ int lds_byte(int r, int c) { const int st = (r >> 4) * 2 + (c >> 5), rr = r & 15, cc = c & 31, ob = rr * 64 + cc * 2; return st * 1024 + (ob ^ (((ob >> 9) & 1) << 5)); }
__host__ __device__ __forceinline__ void stage_rc(int b, int& R, int& C) { const int st = b / 1024, sb = b % 1024, swz = sb ^ (((sb >> 9) & 1) << 5); R = (st >> 1) * 16 + swz / 64; C = (st & 1) * 32 + (swz % 64) / 2; }
__host__ __device__ __forceinline__ int perm32(int rho) { const int n = rho >> 4, i = rho & 15; return 8 * (i >> 2) + 4 * n + (i & 3); }

struct Unit { int pm, pn; };
struct Gemm { const bf16_t* A; const bf16_t* Bt; int M, N, K; };

struct StaticOrder {
    int nM, nN, nwg, G, c, rev;
    __host__ __device__ void init(int M, int N, int G_, int c_, int rev_ = 0) { nM = M / BM; nN = N / BM; nwg = nM * nN; G = G_; c = c_; rev = rev_; }
    __host__ __device__ bool next(int i, Unit& u) const {
        const int nr = (nwg + G - 1) / G; if (i >= nr) return false;
        const long L = (long)(rev ? nr - 1 - i : i) * G + c; if (L >= nwg) return false;
        int wgid = (int)L; { const int q = nwg / NXCD, r = nwg % NXCD, xcd = wgid % NXCD, off = wgid / NXCD; wgid = (xcd < r ? xcd * (q + 1) : r * (q + 1) + (xcd - r) * q) + off; }
        const int nig = WGM * nN, gid = wgid / nig, fm = gid * WGM, gsz = (nM - fm) < WGM ? (nM - fm) : WGM;
        u.pm = fm + ((wgid % nig) % gsz); u.pn = (wgid % nig) / gsz; return true;
    }
    __device__ __forceinline__ void a_ready(const Unit&) const {}
    __device__ __forceinline__ void done(const Unit&) const {}
};


__device__ __forceinline__ unsigned cvt_pk_bf16(float lo, float hi) { unsigned r; asm volatile("v_cvt_pk_bf16_f32 %0, %1, %2" : "=v"(r) : "v"(lo), "v"(hi)); return r; }
constexpr float RMS_EPS = 1e-6f;
constexpr float QSCALE = 0.125f * 1.4426950408889634f;

struct EpiQKV {
    static constexpr bool PERM = true, AFTER_DRAIN = false, NEEDS_RS = true;
    bf16_t* Q; size_t plane; const float* rowss; const float* qg; long kdelta;
    __device__ __forceinline__ void operator()(const f32x4 (&acc)[2][2][4][2], const Unit& u, int wr, int wc, int fr, int fq, const PG8_LAS float* rst) const {
        const int sec = u.pn >> 2, head = 4 * (u.pn & 3) + wc;
        bf16_t* base = Q + (size_t)sec * plane;
        const float* gp = qg + (sec == 1 ? kdelta : 0);
        const float osc = sec == 0 ? QSCALE : 1.0f;
        f32x4 g[2][2];
#pragma unroll
        for (int bj = 0; bj < 2; ++bj)
#pragma unroll
            for (int n = 0; n < 2; ++n) g[bj][n] = *(const f32x4*)(gp + 32 * bj + 8 * fq + 4 * n);
#pragma unroll
        for (int ai = 0; ai < 2; ++ai)
#pragma unroll
            for (int m = 0; m < 4; ++m) {
                const int row = u.pm * BM + ai * HALF + wr * 64 + m * 16 + fr;
                const float rstd = rst[ai * HALF + wr * 64 + m * 16 + fr];
                f32x4 v[2][2]; float ss = 0.f;
#pragma unroll
                for (int bj = 0; bj < 2; ++bj)
#pragma unroll
                    for (int n = 0; n < 2; ++n) { v[bj][n] = acc[ai][bj][m][n] * rstd; const f32x4 t = v[bj][n]; ss += (t[0] * t[0] + t[1] * t[1]) + (t[2] * t[2] + t[3] * t[3]); }
                if (sec < 2) {
                    ss += __shfl_xor(ss, 16); ss += __shfl_xor(ss, 32);
                    const float r = __builtin_amdgcn_rsqf(ss * (1.0f / 64.0f) + RMS_EPS) * osc;
#pragma unroll
                    for (int bj = 0; bj < 2; ++bj)
#pragma unroll
                        for (int n = 0; n < 2; ++n) v[bj][n] = v[bj][n] * r * g[bj][n];
                }
                bf16_t* rowp = base + (size_t)row * 1024 + head * 64 + 8 * fq;
#pragma unroll
                for (int bj = 0; bj < 2; ++bj) { u32x4 w; w.x = cvt_pk_bf16(v[bj][0][0], v[bj][0][1]); w.y = cvt_pk_bf16(v[bj][0][2], v[bj][0][3]); w.z = cvt_pk_bf16(v[bj][1][0], v[bj][1][1]); w.w = cvt_pk_bf16(v[bj][1][2], v[bj][1][3]);
                    *(u32x4*)(rowp + 32 * bj) = w; }
            }
    }
};

__device__ __forceinline__ unsigned short f2h(float f) { _Float16 h = (_Float16)f; return __builtin_bit_cast(unsigned short, h); }
__device__ __forceinline__ float h2f(unsigned short u) { return (float)__builtin_bit_cast(_Float16, u); }
__device__ __forceinline__ unsigned pk_h2(float lo, float hi) { return (unsigned)f2h(lo) | ((unsigned)f2h(hi) << 16); }

struct EpiHgIn {
    static constexpr bool PERM = true, AFTER_DRAIN = false, NEEDS_RS = true;
    bf16_t* Qh; size_t plane; const float* rowss; const float* lbl; int jl;
    __device__ __forceinline__ void operator()(const f32x4 (&acc)[2][2][4][2], const Unit& u, int wr, int wc, int fr, int fq, const PG8_LAS float* rst) const {
        const int sec = u.pn >> 2;
        if (sec == 0) run<0>(acc, u, wr, wc, fr, fq, rst); else if (sec == 1) run<1>(acc, u, wr, wc, fr, fq, rst); else if (sec == 2) run<2>(acc, u, wr, wc, fr, fq, rst); else run<3>(acc, u, wr, wc, fr, fq, rst);
    }
    template <int SEC> __device__ __forceinline__ void run(const f32x4 (&acc)[2][2][4][2], const Unit& u, int wr, int wc, int fr, int fq, const PG8_LAS float* rst) const {
        bf16_t* base = Qh + (size_t)SEC * plane;
        const int col0 = (u.pn & 3) * BM + wc * 32 + 8 * fq;
        f32x4 lb[2][2];
#pragma unroll
        for (int bj = 0; bj < 2; ++bj)
#pragma unroll
            for (int n = 0; n < 2; ++n) { lb[bj][n] = (f32x4){0.f, 0.f, 0.f, 0.f};
                if (SEC == 1 && jl == 1) { const f32x4 l0 = *(const f32x4*)(lbl + col0 + bj * HALF + 4 * n), l1 = *(const f32x4*)(lbl + 1024 + col0 + bj * HALF + 4 * n);
#pragma unroll
                    for (int e = 0; e < 4; ++e) lb[bj][n][e] = __builtin_amdgcn_rcpf(1.0f + __expf(l0[e] - l1[e])); } }
#pragma unroll
        for (int ai = 0; ai < 2; ++ai)
#pragma unroll
            for (int m = 0; m < 4; ++m) {
                const int row = u.pm * BM + ai * HALF + wr * 64 + m * 16 + fr;
                const float rstd = rst[ai * HALF + wr * 64 + m * 16 + fr];
                bf16_t* rowp = base + (size_t)row * 1024 + col0;
#pragma unroll
                for (int bj = 0; bj < 2; ++bj) {
                    float v[8];
#pragma unroll
                    for (int e = 0; e < 8; ++e) v[e] = acc[ai][bj][m][e >> 2][e & 3] * rstd;
                    u32x4 w;
                    if (SEC == 1) {
#pragma unroll
                        for (int e = 0; e < 8; ++e) { const float l = lb[bj][e >> 2][e & 3]; const float sg = __builtin_amdgcn_rcpf(1.0f + __expf(-v[e]));     v[e] = __builtin_amdgcn_logf(l + (1.0f - l) * sg); }
                        w.x = pk_h2(v[0], v[1]); w.y = pk_h2(v[2], v[3]); w.z = pk_h2(v[4], v[5]); w.w = pk_h2(v[6], v[7]);
                    } else {
                        if (SEC == 0) {
#pragma unroll
                            for (int e = 0; e < 8; ++e) v[e] = v[e] * __builtin_amdgcn_rcpf(1.0f + __expf(-v[e]));
                        } else if (SEC == 3) {
#pragma unroll
                            for (int e = 0; e < 8; ++e) v[e] = __builtin_amdgcn_rcpf(1.0f + __expf(-v[e]));
                        }
                        w.x = cvt_pk_bf16(v[0], v[1]); w.y = cvt_pk_bf16(v[2], v[3]); w.z = cvt_pk_bf16(v[4], v[5]); w.w = cvt_pk_bf16(v[6], v[7]);
                    }
                    *(u32x4*)(rowp + bj * HALF) = w;
                }
            }
    }
};

template <bool FINAL> struct EpiRes {
    static constexpr bool PERM = true, AFTER_DRAIN = false, NEEDS_RS = false;
    bf16_t* xh; float* rowss_out; float* out32;
    __device__ __forceinline__ void operator()(const f32x4 (&acc)[2][2][4][2], const Unit& u, int wr, int wc, int fr, int fq) const {
        const int col0 = u.pn * BM + wc * 32 + 8 * fq;
        u32x4 xin[8][2];
#define PG8_RES_LOAD(g) do { _Pragma("unroll") for (int bj = 0; bj < 2; ++bj) xin[g][bj] = *(const u32x4*)(xh + (size_t)(u.pm * BM + ((g) >> 2) * HALF + wr * 64 + ((g) & 3) * 16 + fr) * 1024 + col0 + bj * HALF); } while (0)
#pragma unroll
        for (int g = 0; g < 6; ++g) PG8_RES_LOAD(g);
        asm volatile("" ::: "memory");
#pragma unroll
        for (int g = 0; g < 8; ++g) {
            const int ai = g >> 2, m = g & 3;
            const int row = u.pm * BM + ai * HALF + wr * 64 + m * 16 + fr;
            const size_t off = (size_t)row * 1024 + col0; float ss = 0.f;
#pragma unroll
            for (int bj = 0; bj < 2; ++bj) {
                const u32x4 xw = xin[g][bj];
                const f32x4 x0 = {h2f((unsigned short)(xw.x & 0xffffu)), h2f((unsigned short)(xw.x >> 16)), h2f((unsigned short)(xw.y & 0xffffu)), h2f((unsigned short)(xw.y >> 16))};
                const f32x4 x1 = {h2f((unsigned short)(xw.z & 0xffffu)), h2f((unsigned short)(xw.z >> 16)), h2f((unsigned short)(xw.w & 0xffffu)), h2f((unsigned short)(xw.w >> 16))};
                const f32x4 v0 = x0 + acc[ai][bj][m][0], v1 = x1 + acc[ai][bj][m][1];
                if (FINAL) { *(f32x4*)(out32 + off + bj * HALF) = v0; *(f32x4*)(out32 + off + bj * HALF + 4) = v1; }
                else {
                    u32x4 hw; hw.x = pk_h2(v0[0], v0[1]); hw.y = pk_h2(v0[2], v0[3]); hw.z = pk_h2(v1[0], v1[1]); hw.w = pk_h2(v1[2], v1[3]);
                    *(u32x4*)(xh + off + bj * HALF) = hw;
                    ss += (v0[0] * v0[0] + v0[1] * v0[1]) + (v0[2] * v0[2] + v0[3] * v0[3]) + (v1[0] * v1[0] + v1[1] * v1[1]) + (v1[2] * v1[2] + v1[3] * v1[3]);
                }
            }
            if (!FINAL) { ss += __shfl_xor(ss, 16); ss += __shfl_xor(ss, 32); if (fq == 0) atomicAdd(rowss_out + row, ss); }
            if (g + 6 < 8) PG8_RES_LOAD(g + 6);
            asm volatile("" ::: "memory");
        }
#undef PG8_RES_LOAD
    }
};

struct EpiUp {
    static constexpr bool PERM = true, AFTER_DRAIN = false, NEEDS_RS = true;
    bf16_t* H; const float* rowss;
    __device__ __forceinline__ void operator()(const f32x4 (&acc)[2][2][4][2], const Unit& u, int wr, int wc, int fr, int fq, const PG8_LAS float* rst) const {
        const int col0 = u.pn * BM + wc * 32 + 8 * fq;
#pragma unroll
        for (int ai = 0; ai < 2; ++ai)
#pragma unroll
            for (int m = 0; m < 4; ++m) {
                const int row = u.pm * BM + ai * HALF + wr * 64 + m * 16 + fr;
                const float rstd = rst[ai * HALF + wr * 64 + m * 16 + fr];
                bf16_t* rowp = H + (size_t)row * 4096 + col0;
#pragma unroll
                for (int bj = 0; bj < 2; ++bj) {
                    float v[8];
#pragma unroll
                    for (int e = 0; e < 8; ++e) { const float t = fmaxf(acc[ai][bj][m][e >> 2][e & 3] * rstd, 0.f); v[e] = t * t; }
                    u32x4 w; w.x = cvt_pk_bf16(v[0], v[1]); w.y = cvt_pk_bf16(v[2], v[3]); w.z = cvt_pk_bf16(v[4], v[5]); w.w = cvt_pk_bf16(v[6], v[7]);
                    *(u32x4*)(rowp + bj * HALF) = w;
                }
            }
    }
};

template <class Epi, class Sched, bool ALIGN_EPI = false, bool SP2 = false, bool F16 = false>
__device__ __forceinline__ void gemm_phase(PG8_LAS unsigned char* lds, const Gemm g, const Sched& S, const Epi& E) {
    int tid_ = threadIdx.x; asm volatile("" : "+v"(tid_));
    const int tid = tid_, wid = __builtin_amdgcn_readfirstlane(tid >> 6), lane = tid & 63, wr = wid >> 2, wc = wid & 3, fr = lane & 15, fq = lane >> 4;
    const int K = g.K, nt = K / BK;
    unsigned voffA[2], voffB[2];
#pragma unroll
    for (int i = 0; i < 2; ++i) { int R, C; stage_rc(tid * 16 + i * 8192, R, C); const int Rb = Epi::PERM ? ((R & ~31) + perm32(R & 31)) : R;
        voffA[i] = (unsigned)(R * K + C) * 2u; voffB[i] = (unsigned)(Rb * K + C) * 2u; }
    const size_t kstep = (size_t)(BK * 2);
    const size_t hstep = (size_t)HALF * K * 2;
    const size_t tstep = 2 * hstep;
    const unsigned ldsw = (unsigned)wid * 1024u;
    const int aoff = lds_byte(wr * 64 + fr, fq * 8), boff = lds_byte(wc * 32 + fr, fq * 8);
#define PG8_SA(b, h) (((b) * 2 + (h)) * HTB)
#define PG8_SB(b, h) ((4 + (b) * 2 + (h)) * HTB)
#define PG8_STAGE(bufoff, gbase, voff) do { _Pragma("unroll") for (int _i = 0; _i < 2; ++_i) \
        __builtin_amdgcn_global_load_lds((const unsigned*)((const char*)(gbase) + (voff)[_i]), (PG8_LAS unsigned*)(lds + (bufoff) + ldsw + _i * 8192), 16, 0, 0); } while (0)
#define PG8_LDA(dst, b, h) do { _Pragma("unroll") for (int m = 0; m < 4; ++m) _Pragma("unroll") for (int k = 0; k < 2; ++k) dst[m][k] = *(const PG8_LAS bf16x8*)(lds + PG8_SA(b, h) + aoff + m * 2048 + k * 1024); } while (0)
#define PG8_LDB(dst, b, h) do { _Pragma("unroll") for (int n = 0; n < 2; ++n) _Pragma("unroll") for (int k = 0; k < 2; ++k) dst[n][k] = *(const PG8_LAS bf16x8*)(lds + PG8_SB(b, h) + boff + n * 2048 + k * 1024); } while (0)
#define PG8_MMA(ai, bj, At, Bt) do { __builtin_amdgcn_s_setprio(1); _Pragma("unroll") for (int m = 0; m < 4; ++m) _Pragma("unroll") for (int n = 0; n < 2; ++n) _Pragma("unroll") for (int k = 0; k < 2; ++k) \
        acc[ai][bj][m][n] = F16 ? __builtin_amdgcn_mfma_f32_16x16x32_f16(__builtin_bit_cast(f16x8, Bt[n][k]), __builtin_bit_cast(f16x8, At[m][k]), acc[ai][bj][m][n], 0, 0, 0) \
                                : __builtin_amdgcn_mfma_f32_16x16x32_bf16(Bt[n][k], At[m][k], acc[ai][bj][m][n], 0, 0, 0); __builtin_amdgcn_s_setprio(0); } while (0)
#define PG8_WAIT_V(n) asm volatile("s_waitcnt vmcnt(" #n ")" ::: "memory")
#define PG8_WAIT_L(n) asm volatile("s_waitcnt lgkmcnt(" #n ")" ::: "memory")
#define PG8_BAR __builtin_amdgcn_s_barrier()
#define PG8_SCHED __builtin_amdgcn_sched_barrier(0)
    Unit cur, nxt; int ui = 0;
    if (!S.next(0, cur)) return;
    f32x4 acc[2][2][4][2];
#pragma unroll
    for (int a = 0; a < 2; ++a)
#pragma unroll
        for (int b = 0; b < 2; ++b)
#pragma unroll
            for (int m = 0; m < 4; ++m)
#pragma unroll
                for (int n = 0; n < 2; ++n) acc[a][b][m][n] = (f32x4){0.f, 0.f, 0.f, 0.f};
    bf16x8 At[4][2], B0[2][2], B1[2][2];
    const char* cA = (const char*)g.A + (size_t)cur.pm * tstep; const char* cB = (const char*)g.Bt + (size_t)cur.pn * tstep;
    S.a_ready(cur);
    float rs_pref = 0.f;
    if constexpr (Epi::NEEDS_RS) { if (tid < 256) rs_pref = E.rowss[cur.pm * BM + tid]; }
    if constexpr (SP2) {
        PG8_STAGE(PG8_SB(0, 0), cB, voffB); PG8_STAGE(PG8_SB(0, 1), cB + hstep, voffB); PG8_STAGE(PG8_SA(0, 0), cA, voffA); PG8_STAGE(PG8_SA(0, 1), cA + hstep, voffA);
        if (wr == 1) PG8_BAR;
        PG8_WAIT_V(2); PG8_BAR;
        PG8_STAGE(PG8_SB(1, 0), cB + kstep, voffB); PG8_STAGE(PG8_SA(1, 0), cA + kstep, voffA); PG8_STAGE(PG8_SB(1, 1), cB + hstep + kstep, voffB);
        PG8_WAIT_V(6); PG8_BAR;
    } else {
        PG8_STAGE(PG8_SB(0, 0), cB, voffB); PG8_STAGE(PG8_SA(0, 0), cA, voffA); PG8_STAGE(PG8_SB(0, 1), cB + hstep, voffB); PG8_STAGE(PG8_SA(0, 1), cA + hstep, voffA);
        if (wr == 1) PG8_BAR;
        PG8_WAIT_V(4); PG8_BAR;
        PG8_STAGE(PG8_SB(1, 0), cB + kstep, voffB); PG8_STAGE(PG8_SA(1, 0), cA + kstep, voffA); PG8_STAGE(PG8_SB(1, 1), cB + hstep + kstep, voffB);
        PG8_WAIT_V(6); PG8_BAR;
    }
    for (;;) {
        const bool has_next = S.next(ui + 1, nxt);
        const char* nA = has_next ? (const char*)g.A + (size_t)nxt.pm * tstep : cA; const char* nB = has_next ? (const char*)g.Bt + (size_t)nxt.pn * tstep : cB;
        for (int t = 0; t < nt; t += 2) {
            const bool last = (t == nt - 2);
            const char* a1 = cA + (size_t)(t + 1) * kstep;
            const char* a2 = last ? nA : cA + (size_t)(t + 2) * kstep; const char* b2 = last ? nB : cB + (size_t)(t + 2) * kstep;
            const char* a3 = a2 + kstep; const char* b3 = b2 + kstep;
            if (last && has_next) S.a_ready(nxt);
            if constexpr (SP2) {
            PG8_LDB(B0, 0, 0); PG8_LDB(B1, 0, 1); PG8_SCHED; PG8_LDA(At, 0, 0); PG8_STAGE(PG8_SA(1, 1), a1 + hstep, voffA);
            PG8_WAIT_V(8); PG8_WAIT_L(0); PG8_BAR; PG8_MMA(0, 0, At, B0); PG8_MMA(0, 1, At, B1); PG8_BAR; PG8_SCHED;
            PG8_LDA(At, 0, 1); PG8_STAGE(PG8_SB(0, 0), b2, voffB); PG8_STAGE(PG8_SB(0, 1), b2 + hstep, voffB); PG8_STAGE(PG8_SA(0, 0), a2, voffA);
            PG8_WAIT_V(8); PG8_WAIT_L(0); PG8_BAR; PG8_MMA(1, 0, At, B0); PG8_MMA(1, 1, At, B1); PG8_BAR; PG8_SCHED;
            PG8_LDB(B0, 1, 0); PG8_LDB(B1, 1, 1); PG8_SCHED; PG8_LDA(At, 1, 0); PG8_STAGE(PG8_SA(0, 1), a2 + hstep, voffA);
            PG8_WAIT_V(8); PG8_WAIT_L(0); PG8_BAR; PG8_MMA(0, 0, At, B0); PG8_MMA(0, 1, At, B1); PG8_BAR; PG8_SCHED;
            PG8_LDA(At, 1, 1); PG8_STAGE(PG8_SB(1, 0), b3, voffB); PG8_STAGE(PG8_SB(1, 1), b3 + hstep, voffB); PG8_STAGE(PG8_SA(1, 0), a3, voffA);
            PG8_WAIT_V(8); PG8_WAIT_L(0); PG8_BAR; PG8_MMA(1, 0, At, B0); PG8_MMA(1, 1, At, B1); PG8_BAR; PG8_SCHED;
            } else {
            PG8_LDB(B0, 0, 0); PG8_SCHED; PG8_LDA(At, 0, 0); PG8_STAGE(PG8_SA(1, 1), a1 + hstep, voffA);
            PG8_WAIT_L(8); PG8_BAR; PG8_WAIT_L(0); PG8_MMA(0, 0, At, B0); PG8_BAR; PG8_SCHED;
            PG8_LDB(B1, 0, 1); PG8_STAGE(PG8_SB(0, 0), b2, voffB);
            PG8_BAR; PG8_WAIT_L(0); PG8_MMA(0, 1, At, B1); PG8_BAR;
            PG8_LDA(At, 0, 1); PG8_STAGE(PG8_SA(0, 0), a2, voffA);
            PG8_BAR; PG8_WAIT_L(0); PG8_MMA(1, 0, At, B0); PG8_BAR; PG8_SCHED;
            PG8_STAGE(PG8_SB(0, 1), b2 + hstep, voffB);
            PG8_WAIT_V(6); PG8_BAR; PG8_MMA(1, 1, At, B1); PG8_BAR;
            PG8_LDB(B0, 1, 0); PG8_SCHED; PG8_LDA(At, 1, 0); PG8_STAGE(PG8_SA(0, 1), a2 + hstep, voffA);
            PG8_WAIT_L(8); PG8_BAR; PG8_WAIT_L(0); PG8_MMA(0, 0, At, B0); PG8_BAR; PG8_SCHED;
            PG8_LDB(B1, 1, 1); PG8_STAGE(PG8_SB(1, 0), b3, voffB);
            PG8_BAR; PG8_WAIT_L(0); PG8_MMA(0, 1, At, B1); PG8_BAR;
            PG8_LDA(At, 1, 1); PG8_STAGE(PG8_SA(1, 0), a3, voffA);
            PG8_BAR; PG8_WAIT_L(0); PG8_MMA(1, 0, At, B0); PG8_BAR; PG8_SCHED;
            PG8_STAGE(PG8_SB(1, 1), b3 + hstep, voffB);
            PG8_WAIT_V(6); PG8_BAR; PG8_MMA(1, 1, At, B1); PG8_BAR;
            }
        }
        if constexpr (ALIGN_EPI) { if (wr == 0) PG8_BAR; }
        if constexpr (!Epi::AFTER_DRAIN) {
            if constexpr (Epi::NEEDS_RS) {
                static_assert(ALIGN_EPI, "the row-statistics table needs both half-workgroups in the epilogue at the same time");
                if (tid < 256) *(PG8_LAS float*)(lds + STAGE_BYTES + 256 + tid * 4) = __builtin_amdgcn_rsqf(rs_pref * (1.0f / 1024.0f) + RMS_EPS);
                asm volatile("s_waitcnt lgkmcnt(0)\n\ts_barrier" ::: "memory");
                if (has_next && tid < 256) rs_pref = E.rowss[nxt.pm * BM + tid];
                E(acc, cur, wr, wc, fr, fq, (const PG8_LAS float*)(lds + STAGE_BYTES + 256));
            } else E(acc, cur, wr, wc, fr, fq);
            S.done(cur); }
        if (!has_next) break;
#pragma unroll
        for (int a = 0; a < 2; ++a)
#pragma unroll
            for (int b = 0; b < 2; ++b)
#pragma unroll
                for (int m = 0; m < 4; ++m)
#pragma unroll
                    for (int n = 0; n < 2; ++n) acc[a][b][m][n] = (f32x4){0.f, 0.f, 0.f, 0.f};
        cur = nxt; cA = nA; cB = nB; ++ui;
        if constexpr (ALIGN_EPI) { if (wr == 1) PG8_BAR; }
    }
    PG8_WAIT_V(0);
    if constexpr (!ALIGN_EPI) { if (wr == 0) PG8_BAR; }
    PG8_BAR;
    if constexpr (Epi::AFTER_DRAIN) { E.fused(acc, cur, wr, wc, fr, fq, lds, wid, lane); S.done(cur); }
#undef PG8_SA
#undef PG8_SB
#undef PG8_STAGE
#undef PG8_LDA
#undef PG8_LDB
#undef PG8_MMA
#undef PG8_WAIT_V
#undef PG8_WAIT_L
#undef PG8_BAR
#undef PG8_SCHED
}
}

#define LAS __attribute__((address_space(3)))
typedef unsigned short bf16;
typedef short bf16x8 __attribute__((ext_vector_type(8)));
typedef short s16x4 __attribute__((ext_vector_type(4)));
typedef float f32x4 __attribute__((ext_vector_type(4)));
typedef float f32x16 __attribute__((ext_vector_type(16)));
typedef unsigned u32x4 __attribute__((ext_vector_type(4)));
typedef unsigned u32x2 __attribute__((ext_vector_type(2)));
typedef float f32x2_t __attribute__((ext_vector_type(2)));
typedef __bf16 bf16x2_t __attribute__((ext_vector_type(2)));
#define MFMA32(a, b, c) __builtin_amdgcn_mfma_f32_32x32x16_bf16((a), (b), (c), 0, 0, 0)
__device__ __forceinline__ unsigned cvtpk(float lo, float hi) { f32x2_t v = {lo, hi}; bf16x2_t b = __builtin_convertvector(v, bf16x2_t); return __builtin_bit_cast(unsigned, b); }
__device__ __forceinline__ unsigned short f2bf1(float f) { return (unsigned short)(cvtpk(f, 0.f) & 0xffffu); }
__device__ __forceinline__ float bf2f(unsigned short u) { return __uint_as_float((unsigned)u << 16); }
__device__ __forceinline__ int crow(int r, int hi) { return (r & 3) + 8 * (r >> 2) + 4 * hi; }
__device__ __forceinline__ float ex2(float x) { return __builtin_amdgcn_exp2f(x); }
__device__ __forceinline__ float lg2(float x) { return __builtin_amdgcn_logf(x); }
__device__ __forceinline__ float fmul_s(float a, float b) { float r = a * b; asm("" : "+v"(r)); return r; }
__device__ __forceinline__ float fadd1_s(float a) { return 1.0f + a; }
typedef short v4i16_t __attribute__((ext_vector_type(4)));
__device__ __forceinline__ s16x4 vtr(const LAS unsigned char* p) { return __builtin_bit_cast(s16x4, __builtin_amdgcn_ds_read_tr16_b64_v4i16((LAS v4i16_t*)p)); }

#define XB_TMO      128
#define XB_XCNT(j)  (256  + 64 * (j))
#define XB_XSUB(j)  (1280 + 64 * (j))
#define XB_XGEN(j)  (2304 + 64 * (j))
#define XB_TOP      3328
#define XB_TOPGEN   3392
#define XCD_BAR_WORDS 3456
#define XB_SPIN_CAP (1u << 18)

__device__ __forceinline__ unsigned xb_ld(unsigned* p)              { return __hip_atomic_load(p, __ATOMIC_RELAXED, __HIP_MEMORY_SCOPE_AGENT); }
__device__ __forceinline__ unsigned xb_add(unsigned* p, unsigned v) { return __hip_atomic_fetch_add(p, v, __ATOMIC_RELAXED, __HIP_MEMORY_SCOPE_AGENT); }
__device__ __forceinline__ unsigned xb_xcc_id() { return (unsigned)__builtin_amdgcn_s_getreg((3 << 11) | 20) & 0xFu; }
#define XB_SPIN(cond, bar) do { unsigned _sp = 0; while (cond) { __builtin_amdgcn_s_sleep(1); \
    if ((++_sp & 255u) == 0u) { if (xb_ld(&(bar)[XB_TMO])) break; if (_sp > XB_SPIN_CAP) { atomicAdd(&(bar)[XB_TMO], 1u); break; } } } } while (0)

struct XcdBarrier {
    unsigned* bar; unsigned x;
    volatile LAS unsigned* st;
};

__device__ __forceinline__ XcdBarrier xcd_barrier_post(unsigned* bar, volatile LAS unsigned* st) {
    XcdBarrier b; b.bar = bar; b.x = xb_xcc_id(); b.st = st;
    if (threadIdx.x == 0) (void)xb_add(&bar[XB_XCNT(b.x)], 1u);
    return b;
}
__device__ __forceinline__ void xcd_barrier_complete(unsigned* bar, unsigned x, unsigned& nloc, unsigned& nx) {
    const unsigned G = gridDim.x * gridDim.y * gridDim.z;
    unsigned sum, cnt, mine, sp = 0u;
    for (;;) {
        sum = 0u; cnt = 0u; mine = 0u;
#pragma unroll
        for (unsigned j = 0; j < 16; ++j) { const unsigned c = xb_ld(&bar[XB_XCNT(j)]); sum += c; cnt += (c > 0u) ? 1u : 0u; mine = (j == x) ? c : mine; }
        if (sum == G) break;
        __builtin_amdgcn_s_sleep(1);
        if ((++sp & 255u) == 0u) { if (xb_ld(&bar[XB_TMO])) break; if (sp > XB_SPIN_CAP) { atomicAdd(&bar[XB_TMO], 1u); break; } }
    }
    nloc = mine > 0u ? mine : 1u; nx = cnt > 0u ? cnt : 1u;
}

__device__ __forceinline__ void xcd_barrier(const XcdBarrier& b) {
    asm volatile("s_waitcnt vmcnt(0)" ::: "memory");
    __syncthreads();
    if (threadIdx.x == 0) {
        unsigned* bar = b.bar;
        __builtin_amdgcn_s_waitcnt(0);
        unsigned nloc = b.st[0], nx = b.st[1];
        if (nloc == 0u) { xcd_barrier_complete(bar, b.x, nloc, nx); b.st[0] = nloc; b.st[1] = nx; }
        const unsigned old = xb_add(&bar[XB_XSUB(b.x)], 1u);
        const unsigned gen = old / nloc;
        if (old + 1u == (gen + 1u) * nloc) {
            __builtin_amdgcn_fence(__ATOMIC_RELEASE, "agent");
            asm volatile("s_waitcnt vmcnt(0)" ::: "memory");
            const unsigned og = xb_add(&bar[XB_TOP], 1u);
            const unsigned tg = og / nx;
            if (og + 1u == (tg + 1u) * nx) xb_add(&bar[XB_TOPGEN], 1u);
            else XB_SPIN(xb_ld(&bar[XB_TOPGEN]) == tg, bar);
            __builtin_amdgcn_fence(__ATOMIC_ACQUIRE, "agent");
            xb_add(&bar[XB_XGEN(b.x)], 1u);
            asm volatile("s_waitcnt vmcnt(0)" ::: "memory");
        } else {
            XB_SPIN(xb_ld(&bar[XB_XGEN(b.x)]) == gen, bar);
            __builtin_amdgcn_fence(__ATOMIC_ACQUIRE, "agent");
            asm volatile("s_waitcnt vmcnt(0)" ::: "memory");
        }
    }
    __syncthreads();
}

constexpr int BATCH = 8, SEQ = 4096, DM = 1024, FF = 4096, MTOK = BATCH * SEQ, DEPTH = 4;

namespace sba {
constexpr int KSTR = 144, TROWS = 128, TILE_B = TROWS * KSTR;
constexpr int LDS_K = 0, LDS_V = 2 * TILE_B, LDS_FLG = 4 * TILE_B, LDS_BYTES = LDS_FLG + 64;

template <bool MASK>
__device__ __forceinline__ void block32(const LAS unsigned char* Kb, const LAS unsigned char* Vb, int kb, const bf16x8 (&qr)[4], f32x16 (&o)[2], float& R, int lim, int r32, int hi, int lane) {
    f32x16 p = {};
    const LAS unsigned char* kp = Kb + (32 * kb + r32) * KSTR + hi * 16;
#pragma unroll
    for (int s = 0; s < 4; ++s) { const bf16x8 kf = *(const LAS bf16x8*)(kp + s * 32); p = MFMA32(kf, qr[s], p); }
    float e[16], u[16];
#pragma unroll
    for (int i = 0; i < 16; ++i) { float v = ex2(p[i]); if (MASK) v = ((i & 3) + 8 * (i >> 2) < lim) ? v : 0.f; e[i] = v; u[i] = fadd1_s(v); }
    float pab[4], pabc[4], rG[4], tm[4], om1[4];
#pragma unroll
    for (int m = 0; m < 4; ++m) {
        pab[m] = fmul_s(u[4 * m], u[4 * m + 1]); pabc[m] = fmul_s(pab[m], u[4 * m + 2]); rG[m] = __builtin_amdgcn_rcpf(fmul_s(pabc[m], u[4 * m + 3]));
        const unsigned own = __float_as_uint(rG[m]);
        auto sw = __builtin_amdgcn_permlane32_swap(own, own, false, false);
        tm[m] = fmul_s(__uint_as_float(sw[0]), __uint_as_float(sw[1]));
        om1[m] = (hi == 0) ? __uint_as_float(sw[1]) : 1.0f;
    }
    float T[4]; T[3] = 1.0f; T[2] = tm[3]; T[1] = fmul_s(tm[3], tm[2]); T[0] = fmul_s(T[1], tm[1]);
    float w[16];
#pragma unroll
    for (int m = 0; m < 4; ++m) {
        const float base = fmul_s(fmul_s(R, T[m]), fmul_s(om1[m], rG[m]));
        w[4 * m] = fmul_s(e[4 * m], base); w[4 * m + 1] = fmul_s(e[4 * m + 1], fmul_s(base, u[4 * m])); w[4 * m + 2] = fmul_s(e[4 * m + 2], fmul_s(base, pab[m])); w[4 * m + 3] = fmul_s(e[4 * m + 3], fmul_s(base, pabc[m]));
    }
    R = fmul_s(R, fmul_s(T[0], tm[0]));
    const int q4 = (lane & 15) >> 2, pp = lane & 3, blk = (lane >> 4) & 1;
#pragma unroll
    for (int s = 0; s < 2; ++s) {
        u32x4 pk; pk.x = cvtpk(w[8 * s], w[8 * s + 1]); pk.y = cvtpk(w[8 * s + 2], w[8 * s + 3]); pk.z = cvtpk(w[8 * s + 4], w[8 * s + 5]); pk.w = cvtpk(w[8 * s + 6], w[8 * s + 7]);
        const bf16x8 pb = __builtin_bit_cast(bf16x8, pk);
#pragma unroll
        for (int db = 0; db < 2; ++db) {
            const LAS unsigned char* vp = Vb + (32 * kb + 16 * s + 4 * hi + q4) * KSTR + (32 * db + 16 * blk) * 2 + 8 * pp;
            const s16x4 lo = vtr(vp), hh = vtr(vp + 8 * KSTR);
            const bf16x8 va = __builtin_shufflevector(lo, hh, 0, 1, 2, 3, 4, 5, 6, 7);
            o[db] = MFMA32(va, pb, o[db]);
        }
    }
}

__device__ __forceinline__ void unit(const bf16* Q, const bf16* K, const bf16* V, bf16* O, int b, int h, int qb, LAS unsigned char* lds) {
    int tid_ = threadIdx.x; asm volatile("" : "+v"(tid_));
    const int tid = tid_, lane = tid & 63, r32 = lane & 31, hi = lane >> 5; const int wid = __builtin_amdgcn_readfirstlane(tid >> 6);
    const size_t rowbase = (size_t)b * SEQ; const int q0 = qb * 256;
    const int qabs = q0 + 32 * wid + r32;
    const bf16* Qw = Q + (rowbase + qabs) * DM + h * 64;
    bf16x8 qr[4];
#pragma unroll
    for (int s = 0; s < 4; ++s) qr[s] = *(const bf16x8*)(Qw + 16 * s + 8 * hi);
    const int srow = tid >> 3, sch = tid & 7;
    const bf16* Ks = K + (rowbase + srow) * DM + h * 64 + sch * 8;
    const bf16* Vs = V + (rowbase + srow) * DM + h * 64 + sch * 8;
    const int sdst = srow * KSTR + sch * 16;
    const int NT = (q0 + 256) / TROWS;
    f32x16 o[2]; o[0] = f32x16{}; o[1] = f32x16{};
    float R = 1.0f;
    __syncthreads();
    { const size_t g0 = (size_t)(NT - 1) * TROWS * DM;
      const u32x4 k0 = *(const u32x4*)(Ks + g0), k1 = *(const u32x4*)(Ks + g0 + 64 * DM), v0 = *(const u32x4*)(Vs + g0), v1 = *(const u32x4*)(Vs + g0 + 64 * DM);
      *(LAS u32x4*)(lds + LDS_K + sdst) = k0; *(LAS u32x4*)(lds + LDS_K + sdst + 64 * KSTR) = k1; *(LAS u32x4*)(lds + LDS_V + sdst) = v0; *(LAS u32x4*)(lds + LDS_V + sdst + 64 * KSTR) = v1; }
    __syncthreads();
    const int qmin = q0 + 32 * wid, qmax = qmin + 31;
    bool wdone = false;
    LAS unsigned* flg = (LAS unsigned*)(lds + LDS_FLG);
    int it = 0;
    for (int t = NT - 1; t >= 0; --t, ++it) {
        const int cur = (NT - 1 - t) & 1;
        u32x4 kn0 = {}, kn1 = {}, vn0 = {}, vn1 = {};
        if (t > 0) { const size_t g0 = (size_t)(t - 1) * TROWS * DM; kn0 = *(const u32x4*)(Ks + g0); kn1 = *(const u32x4*)(Ks + g0 + 64 * DM); vn0 = *(const u32x4*)(Vs + g0); vn1 = *(const u32x4*)(Vs + g0 + 64 * DM); }
        const LAS unsigned char* Kb = lds + LDS_K + cur * TILE_B; const LAS unsigned char* Vb = lds + LDS_V + cur * TILE_B;
        if (!wdone) {
            if (TROWS * t + TROWS - 1 < qmin) {
#pragma unroll 1
                for (int kbi = 0; kbi < 4; kbi += 2) {
                    block32<false>(Kb, Vb, 3 - kbi, qr, o, R, 0, r32, hi, lane); block32<false>(Kb, Vb, 2 - kbi, qr, o, R, 0, r32, hi, lane);
                    wdone = (__ballot(R == 0.0f) == ~0ull); if (wdone) break;
                }
            } else {
#pragma unroll 1
                for (int kbi = 0; kbi < 4; ++kbi) {
                    const int kb = 3 - kbi, kv0 = TROWS * t + 32 * kb;
                    if (kv0 < qmax) {
                        if (kv0 + 31 < qmin) block32<false>(Kb, Vb, kb, qr, o, R, 0, r32, hi, lane);
                        else block32<true>(Kb, Vb, kb, qr, o, R, qabs - kv0 - 4 * hi, r32, hi, lane);
                        wdone = (__ballot(R == 0.0f) == ~0ull); if (wdone) break;
                    }
                }
            }
        }
        if (t > 0) { LAS unsigned char* kd = lds + LDS_K + (cur ^ 1) * TILE_B + sdst; LAS unsigned char* vd = lds + LDS_V + (cur ^ 1) * TILE_B + sdst;
            *(LAS u32x4*)kd = kn0; *(LAS u32x4*)(kd + 64 * KSTR) = kn1; *(LAS u32x4*)vd = vn0; *(LAS u32x4*)(vd + 64 * KSTR) = vn1; }
        if (lane == 0) flg[(it & 1) * 8 + wid] = wdone ? 1u : 0u;
        __syncthreads();
        const u32x4 f0 = *(const LAS u32x4*)(flg + (it & 1) * 8), f1 = *(const LAS u32x4*)(flg + (it & 1) * 8 + 4);
        if ((f0.x & f0.y & f0.z & f0.w & f1.x & f1.y & f1.z & f1.w) != 0u) break;
    }
    bf16* Ow = O + (rowbase + qabs) * DM + h * 64;
#pragma unroll
    for (int db = 0; db < 2; ++db)
#pragma unroll
        for (int g = 0; g < 4; ++g) { u32x2 w; w.x = cvtpk(o[db][4 * g], o[db][4 * g + 1]); w.y = cvtpk(o[db][4 * g + 2], o[db][4 * g + 3]);
            *(u32x2*)(Ow + 32 * db + 8 * g + 4 * hi) = w; }
}

__device__ __forceinline__ void phase(const bf16* Q, const bf16* K, const bf16* V, bf16* O, LAS unsigned char* lds, int vcu, int G) {
    for (int pi = vcu; pi < BATCH * 16 * 8; pi += G) {
        const int bh = pi >> 3, sx = pi & 7;
        unit(Q, K, V, O, bh >> 4, bh & 15, 15 - sx, lds);
        unit(Q, K, V, O, bh >> 4, bh & 15, sx, lds);
    }
}
}

namespace hgs {
#define HGS_BAR() asm volatile("s_waitcnt lgkmcnt(0)\n\ts_barrier" ::: "memory")
constexpr int RS = 272, RS2 = 144;
typedef float f32x2v __attribute__((ext_vector_type(2)));
constexpr int P_QD = 0, P_KD = 64 * RS, P_SEG = 2 * 64 * RS, P_BYTES = P_SEG + 8 * 128 * 4;

__device__ __forceinline__ void pre_phase(bf16* Qh, bf16* LF, bf16* SCG, float* CT, LAS unsigned char* lds, int vcu, int G) {
    int tid_ = threadIdx.x; asm volatile("" : "+v"(tid_));
    const int tid = tid_, lane = tid & 63, r32 = lane & 31, hi = lane >> 5; const int wid = __builtin_amdgcn_readfirstlane(tid >> 6);
    const int kp = lane, seg = wid;
    constexpr int NITEM = BATCH * 8 * (SEQ / 64);
#define PRE_CI(s_) ((((s_) & (NITEM / 2 - 1)) >> 5) * 64 + (((s_) & 31) + ((s_) < NITEM / 2 ? 32 : 0)))
    __syncthreads();
    unsigned nq[8], nf[8];
    int it = vcu;
    if (it < NITEM) { const int ci0 = PRE_CI(it), bh = ci0 >> 6, cc = ci0 & 63; const size_t o0 = ((size_t)(bh >> 3) * SEQ + cc * 64 + 8 * seg) * DM + (bh & 7) * 128 + 2 * kp;
#pragma unroll
        for (int j = 0; j < 8; ++j) { nq[j] = *(const unsigned*)(Qh + o0 + (size_t)j * DM); nf[j] = *(const unsigned*)(LF + o0 + (size_t)j * DM); } }
    for (; it < NITEM; it += G) {
        const int ci = PRE_CI(it), bh = ci >> 6, cc = ci & 63; const size_t o0 = ((size_t)(bh >> 3) * SEQ + cc * 64 + 8 * seg) * DM + (bh & 7) * 128 + 2 * kp;
        float q0[8], q1[8], b0[8], b1[8], k0[8], k1[8];
        float run0 = 0.f, run1 = 0.f;
#pragma unroll
        for (int j = 0; j < 8; ++j) {
            q0[j] = __uint_as_float(nq[j] << 16); q1[j] = __uint_as_float(nq[j] & 0xffff0000u);
            const float l0 = pg8::h2f((unsigned short)(nf[j] & 0xffffu)), l1 = pg8::h2f((unsigned short)(nf[j] >> 16));
            k0[j] = 1.0f - ex2(l0); k1[j] = 1.0f - ex2(l1); run0 += l0; run1 += l1; b0[j] = run0; b1[j] = run1;
        }
        if (it + G < NITEM) { const int it2 = PRE_CI(it + G), bh2 = it2 >> 6, cc2 = it2 & 63; const size_t o2 = ((size_t)(bh2 >> 3) * SEQ + cc2 * 64 + 8 * seg) * DM + (bh2 & 7) * 128 + 2 * kp;
#pragma unroll
            for (int j = 0; j < 8; ++j) { nq[j] = *(const unsigned*)(Qh + o2 + (size_t)j * DM); nf[j] = *(const unsigned*)(LF + o2 + (size_t)j * DM); } }
        *(LAS f32x2v*)(lds + P_SEG + (seg * 128 + 2 * kp) * 4) = (f32x2v){run0, run1};
        HGS_BAR();
        {
            float off0 = 0.f, off1 = 0.f, br0 = 0.f, br1 = 0.f, tot0 = 0.f, tot1 = 0.f;
#pragma unroll
            for (int s = 0; s < 8; ++s) { const f32x2v v = *(const LAS f32x2v*)(lds + P_SEG + (s * 128 + 2 * kp) * 4);
                if (s == 4) { br0 = tot0; br1 = tot1; }
                if (s == seg) { off0 = tot0; off1 = tot1; }
                tot0 += v.x; tot1 += v.y; }
            if (seg == 0) { float* ct = CT + (size_t)ci * 384 + 2 * kp;
                *(f32x2v*)(ct) = (f32x2v){ex2(br0), ex2(br1)}; *(f32x2v*)(ct + 128) = (f32x2v){ex2(tot0 - br0), ex2(tot1 - br1)}; *(f32x2v*)(ct + 256) = (f32x2v){ex2(tot0), ex2(tot1)}; }
            off0 -= br0; off1 -= br1;
#pragma unroll
            for (int j = 0; j < 8; ++j) {
                const float d0 = off0 + b0[j], d1 = off1 + b1[j];
                const unsigned qd = cvtpk(q0[j] * ex2(d0), q1[j] * ex2(d1)), kd = cvtpk(k0[j] * ex2(-d0), k1[j] * ex2(-d1));
                const int t = 8 * seg + j;
                *(LAS unsigned*)(lds + P_QD + t * RS + 4 * kp) = qd; *(LAS unsigned*)(lds + P_KD + t * RS + 4 * kp) = kd;
                *(unsigned*)(Qh + o0 + (size_t)j * DM) = qd; *(unsigned*)(LF + o0 + (size_t)j * DM) = kd;
            }
        }
        HGS_BAR();
        if (wid < 3) {
            const int tb = wid == 0 ? 0 : 1, sb = wid == 2 ? 1 : 0;
            f32x16 a = {};
            const LAS unsigned char* ap = lds + P_QD + (32 * tb + r32) * RS + hi * 16;
            const LAS unsigned char* bp = lds + P_KD + (32 * sb + r32) * RS + hi * 16;
#pragma unroll
            for (int s = 0; s < 8; ++s) a = MFMA32(*(const LAS bf16x8*)(ap + s * 32), *(const LAS bf16x8*)(bp + s * 32), a);
            bf16* sg = SCG + (size_t)ci * 4096 + 32 * sb + r32;
#pragma unroll
            for (int i = 0; i < 16; ++i) { const int t = 32 * tb + crow(i, hi), s_ = 32 * sb + r32; sg[t * 64] = f2bf1((s_ <= t) ? a[i] : 0.f); }
        }
        HGS_BAR();
    }
}

constexpr int S_QD = 0, S_KD = 64 * RS, S_SC = 2 * 64 * RS, S_VT = S_SC + 64 * RS2, S_CT = S_VT + 32 * RS2, S_BUF = S_CT + 1536, S_ST = 2 * S_BUF, S_YB = S_ST + 32 * RS, S_CTS = S_YB + 2 * 4096, S_ST2 = S_CTS + 3 * 1536, LDS_BYTES = S_ST2 + 32 * RS;
static_assert(S_BUF % 16 == 0 && LDS_BYTES <= 131072, "hgs scan LDS map");

struct Pref { u32x4 q0, q1, k0, k1, s; f32x4 c; u32x2 v; };
struct Ctx { const bf16* qsrc; const bf16* ksrc; const bf16* ssrc; const float* csrc; const bf16* vsrc; bf16* ydst; int qdst, sdst, vs, vv, tid, lane, r32, hi, wid, q4, pp, blk; };

__device__ __forceinline__ void fetch(Pref& P, const Ctx& X, int c) {
    const size_t a = (size_t)c * 64 * DM;
    P.q0 = *(const u32x4*)(X.qsrc + a); P.q1 = *(const u32x4*)(X.qsrc + a + 32 * DM); P.k0 = *(const u32x4*)(X.ksrc + a); P.k1 = *(const u32x4*)(X.ksrc + a + 32 * DM);
    P.s = *(const u32x4*)(X.ssrc + (size_t)c * 4096); P.c = *(const f32x4*)(X.csrc + (size_t)(c + 1 < SEQ / 64 ? c + 1 : SEQ / 64 - 1) * 384);     P.v = *(const u32x2*)(X.vsrc + a);
}

__device__ __forceinline__ void chunk(Pref& P, const Ctx& X, int c, int m3, LAS unsigned char* lds, f32x16& st) {
    const int tid = X.tid, r32 = X.r32, hi = X.hi, wid = X.wid;
    LAS unsigned char* bufp = lds + (c & 1) * S_BUF;
    *(LAS u32x4*)(bufp + S_QD + X.qdst) = P.q0; *(LAS u32x4*)(bufp + S_QD + X.qdst + 32 * RS) = P.q1;
    *(LAS u32x4*)(bufp + S_KD + X.qdst) = P.k0; *(LAS u32x4*)(bufp + S_KD + X.qdst + 32 * RS) = P.k1;
    *(LAS u32x4*)(bufp + S_SC + X.sdst) = P.s;
    *(LAS f32x4*)(lds + S_CTS + ((m3 + 1) % 3) * 1536 + (tid < 96 ? tid : 95) * 16) = P.c;
    *(LAS unsigned short*)(bufp + S_VT + (X.vv + 0) * RS2 + X.vs * 2) = (unsigned short)(P.v.x & 0xffffu);
    *(LAS unsigned short*)(bufp + S_VT + (X.vv + 1) * RS2 + X.vs * 2) = (unsigned short)(P.v.x >> 16);
    *(LAS unsigned short*)(bufp + S_VT + (X.vv + 2) * RS2 + X.vs * 2) = (unsigned short)(P.v.y & 0xffffu);
    *(LAS unsigned short*)(bufp + S_VT + (X.vv + 3) * RS2 + X.vs * 2) = (unsigned short)(P.v.y >> 16);
    fetch(P, X, c + 3 < SEQ / 64 ? c + 3 : SEQ / 64 - 1);
    HGS_BAR();
    { const int cp = c > 0 ? c - 1 : 0;
      *(u32x2*)(X.ydst + (size_t)cp * 64 * DM) = *(const LAS u32x2*)(lds + S_YB + (cp & 1) * 4096 + tid * 8); }
    LAS unsigned char* st_rd = lds + ((c & 1) ? S_ST2 : S_ST);
    LAS unsigned char* st_wr = lds + ((c & 1) ? S_ST : S_ST2);
    if (wid >= 4) {
        const int kb4 = wid - 4;
        const LAS float* ct = (const LAS float*)(lds + S_CTS + m3 * 1536); const LAS float* cs = ct + 128; const LAS float* dec = ct + 256;
        const LAS float* cin = (const LAS float*)(lds + S_CTS + ((m3 + 1) % 3) * 1536);
        f32x16 d = {};
        const LAS unsigned char* ap = bufp + S_KD + (8 * hi + X.q4) * RS + (32 * kb4 + 16 * X.blk) * 2 + 8 * X.pp;
        const LAS unsigned char* bp = bufp + S_VT + r32 * RS2 + hi * 16;
#pragma unroll
        for (int s = 0; s < 4; ++s) { const s16x4 lo = vtr(ap + 16 * s * RS), hh = vtr(ap + (16 * s + 4) * RS);
            d = MFMA32(__builtin_shufflevector(lo, hh, 0, 1, 2, 3, 4, 5, 6, 7), *(const LAS bf16x8*)(bp + s * 32), d); }
#pragma unroll
        for (int g = 0; g < 4; ++g) { const f32x4 d4 = *(const LAS f32x4*)(dec + 32 * kb4 + 8 * g + 4 * hi), s4 = *(const LAS f32x4*)(cs + 32 * kb4 + 8 * g + 4 * hi), c4 = *(const LAS f32x4*)(cin + 32 * kb4 + 8 * g + 4 * hi);
#pragma unroll
            for (int e = 0; e < 4; ++e) st[4 * g + e] = st[4 * g + e] * d4[e] + d[4 * g + e] * s4[e];
            u32x2 w; w.x = cvtpk(st[4 * g] * c4[0], st[4 * g + 1] * c4[1]); w.y = cvtpk(st[4 * g + 2] * c4[2], st[4 * g + 3] * c4[3]);
            *(LAS u32x2*)(st_wr + r32 * RS + (32 * kb4 + 8 * g + 4 * hi) * 2) = w; }
    } else if (wid < 2) {
        const int tb = wid;
        f32x16 a = {};
        const LAS unsigned char* ap = bufp + S_QD + (32 * tb + r32) * RS + hi * 16;
        const LAS unsigned char* bp = st_rd + r32 * RS + hi * 16;
#pragma unroll
        for (int s = 0; s < 8; ++s) a = MFMA32(*(const LAS bf16x8*)(ap + s * 32), *(const LAS bf16x8*)(bp + s * 32), a);
        const LAS unsigned char* cp = bufp + S_SC + (32 * tb + r32) * RS2 + hi * 16;
        const LAS unsigned char* vp = bufp + S_VT + r32 * RS2 + hi * 16;
#pragma unroll
        for (int s = 0; s < 4; ++s) if (s < 2 || tb == 1) a = MFMA32(*(const LAS bf16x8*)(cp + s * 32), *(const LAS bf16x8*)(vp + s * 32), a);
        LAS unsigned char* yb = lds + S_YB + (c & 1) * 4096 + (32 * tb) * 64 + r32 * 2;
#pragma unroll
        for (int i = 0; i < 16; ++i) *(LAS unsigned short*)(yb + crow(i, hi) * 64) = f2bf1(a[i]);
    }
}

__device__ __forceinline__ void item(const bf16* QD, const bf16* KD, const bf16* Iv, const bf16* SCG, const float* CT, bf16* Y, int b, int h, int vq, LAS unsigned char* lds) {
    int tid_ = threadIdx.x; asm volatile("" : "+v"(tid_));
    Ctx X;
    X.tid = tid_; X.lane = X.tid & 63; X.r32 = X.lane & 31; X.hi = X.lane >> 5; X.wid = __builtin_amdgcn_readfirstlane(X.tid >> 6);
    const int tid = X.tid;
    const size_t tokb = (size_t)b * SEQ;
    X.qsrc = QD + (tokb + (tid >> 4)) * DM + h * 128 + (tid & 15) * 8;
    X.ksrc = KD + (tokb + (tid >> 4)) * DM + h * 128 + (tid & 15) * 8;
    X.qdst = (tid >> 4) * RS + (tid & 15) * 16;
    X.ssrc = SCG + (size_t)((b * 8 + h) * 64) * 4096 + (tid >> 3) * 64 + (tid & 7) * 8;
    X.sdst = (tid >> 3) * RS2 + (tid & 7) * 16;
    X.csrc = CT + (size_t)((b * 8 + h) * 64) * 384 + (tid < 96 ? tid : 95) * 4;
    X.vs = tid >> 3; X.vv = (tid & 7) * 4;
    X.vsrc = Iv + (tokb + X.vs) * DM + h * 128 + vq * 32 + X.vv;
    X.ydst = Y + (tokb + (tid >> 3)) * DM + h * 128 + vq * 32 + (tid & 7) * 4;
    X.q4 = (X.lane & 15) >> 2; X.pp = X.lane & 3; X.blk = (X.lane >> 4) & 1;
    f32x16 st = {};
    __syncthreads();
    Pref p0, p1, p2;
    { const f32x4 c0 = *(const f32x4*)(X.csrc); *(LAS f32x4*)(lds + S_CTS + (tid < 96 ? tid : 95) * 16) = c0; }
    for (int i = tid; i < 32 * RS / 4; i += 512) ((LAS unsigned*)(lds + S_ST))[i] = 0u;
    fetch(p0, X, 0); fetch(p1, X, 1); fetch(p2, X, 2);
    static_assert((SEQ / 64) % 3 == 1, "chunk loop: 21 x 3 + 1");
    for (int c = 0; c + 1 < SEQ / 64; c += 3) { chunk(p0, X, c, 0, lds, st); chunk(p1, X, c + 1, 1, lds, st); chunk(p2, X, c + 2, 2, lds, st); }
    chunk(p0, X, SEQ / 64 - 1, 0, lds, st);
    HGS_BAR();
    *(u32x2*)(X.ydst + (size_t)(SEQ / 64 - 1) * 64 * DM) = *(const LAS u32x2*)(lds + S_YB + ((SEQ / 64 - 1) & 1) * 4096 + tid * 8);
}

__device__ __forceinline__ void phase(const bf16* QD, const bf16* KD, const bf16* Iv, const bf16* SCG, const float* CT, bf16* Y, LAS unsigned char* lds, int vcu, int G) {
    for (int it = vcu; it < BATCH * 8 * 4; it += G) { const int bh = it >> 2; item(QD, KD, Iv, SCG, CT, Y, bh >> 3, bh & 7, it & 3, lds); }
}

__device__ __forceinline__ void norm_phase(const bf16* Y, const bf16* G, const float* gain, bf16* O, int gw, int ngw, int lane_) {
    int lane = lane_; asm volatile("" : "+v"(lane));
    float gn[16];
#pragma unroll
    for (int e = 0; e < 16; ++e) gn[e] = gain[(lane & 7) * 16 + e];
    for (int row = gw; row < MTOK; row += ngw) {
        const size_t off = (size_t)row * DM + lane * 16;
        const u32x4 y0 = *(const u32x4*)(Y + off), y1 = *(const u32x4*)(Y + off + 8), g0 = *(const u32x4*)(G + off), g1 = *(const u32x4*)(G + off + 8);
        const unsigned yw[8] = {y0.x, y0.y, y0.z, y0.w, y1.x, y1.y, y1.z, y1.w}, gw_[8] = {g0.x, g0.y, g0.z, g0.w, g1.x, g1.y, g1.z, g1.w};
        float yv[16], gv[16]; float ss = 0.f;
#pragma unroll
        for (int e = 0; e < 8; ++e) { yv[2 * e] = __uint_as_float(yw[e] << 16); yv[2 * e + 1] = __uint_as_float(yw[e] & 0xffff0000u); gv[2 * e] = __uint_as_float(gw_[e] << 16); gv[2 * e + 1] = __uint_as_float(gw_[e] & 0xffff0000u); }
#pragma unroll
        for (int e = 0; e < 16; ++e) ss += yv[e] * yv[e];
        ss += __shfl_xor(ss, 1); ss += __shfl_xor(ss, 2); ss += __shfl_xor(ss, 4);
        const float r = __builtin_amdgcn_rsqf(ss * (1.0f / 128.0f) + 1e-6f);
        unsigned ow[8];
#pragma unroll
        for (int e = 0; e < 8; ++e) ow[e] = cvtpk(yv[2 * e] * r * gn[2 * e] * gv[2 * e], yv[2 * e + 1] * r * gn[2 * e + 1] * gv[2 * e + 1]);
        *(u32x4*)(O + off) = (u32x4){ow[0], ow[1], ow[2], ow[3]}; *(u32x4*)(O + off + 8) = (u32x4){ow[4], ow[5], ow[6], ow[7]};
    }
}
}

constexpr size_t MiB = 1u << 20;
constexpr size_t WS_ROWSS = 0;
constexpr size_t WS_BAR = 1536 * 1024;
constexpr size_t WS_W = 2 * MiB;
constexpr size_t W_SBQKV = WS_W, W_SBO = W_SBQKV + 2 * 6 * MiB, W_HGIN = W_SBO + 2 * 2 * MiB, W_HGO = W_HGIN + 2 * 8 * MiB, W_W1 = W_HGO + 2 * 2 * MiB, W_W2 = W_W1 + 4 * 8 * MiB;
constexpr size_t WS_XB = 104 * MiB;
constexpr size_t WS_BIG = 168 * MiB;
constexpr size_t WS_XH = WS_BIG + 256 * MiB;
constexpr size_t WS_END = WS_XH + 64 * MiB;
static_assert(W_W2 + 4 * 8 * MiB <= WS_XB, "weights fit");
constexpr int LDS_BYTES = 135168;

template <bool QKVPERM, bool F16OUT>
__device__ __forceinline__ void transpose_item(const float* W, int K, int N, const float* gain, bf16* WT, LAS float* scr, int item, int lane) {
    const int nblk = N / 32, kb = item / nblk, nb = item % nblk, k0 = 64 * kb, n0 = 32 * nb;
#pragma unroll 8
    for (int i = 0; i < 8; ++i) { const int kk = 8 * i + (lane >> 3); const float gk = gain ? gain[k0 + kk] : 1.0f;
        const f32x4 v = *(const f32x4*)(W + (size_t)(k0 + kk) * N + n0 + (lane & 7) * 4); LAS float* d = scr + kk * 33 + (lane & 7) * 4; d[0] = v[0] * gk; d[1] = v[1] * gk; d[2] = v[2] * gk; d[3] = v[3] * gk; }
    asm volatile("s_waitcnt lgkmcnt(0)" ::: "memory");
    int r0 = n0;
    if (QKVPERM) { const int sec = n0 >> 10, nn = n0 & 1023, pnl = nn >> 8, wc = (nn & 255) >> 6, bj = (nn & 63) >> 5; r0 = sec * 1024 + pnl * 256 + bj * 128 + wc * 32; }
    const int c = lane & 7;
#pragma unroll
    for (int j = 0; j < 4; ++j) { const int n = (lane >> 3) + 8 * j; const LAS float* s = scr + (8 * c) * 33 + n;
        u32x4 o;
        if (F16OUT) { o.x = pg8::pk_h2(s[0 * 33], s[1 * 33]); o.y = pg8::pk_h2(s[2 * 33], s[3 * 33]); o.z = pg8::pk_h2(s[4 * 33], s[5 * 33]); o.w = pg8::pk_h2(s[6 * 33], s[7 * 33]); }
        else { o.x = cvtpk(s[0 * 33], s[1 * 33]); o.y = cvtpk(s[2 * 33], s[3 * 33]); o.z = cvtpk(s[4 * 33], s[5 * 33]); o.w = cvtpk(s[6 * 33], s[7 * 33]); }
        *(u32x4*)(WT + (size_t)(r0 + n) * K + k0 + 8 * c) = o; }
    asm volatile("s_waitcnt lgkmcnt(0)" ::: "memory");
}

struct Args { const float* in[12]; float* out; unsigned char* ws; };

__global__ void __launch_bounds__(512, 2) trunk_fwd(Args args) {
    extern __shared__ __attribute__((aligned(16))) unsigned char lds_raw[];
    cg::grid_group grid = cg::this_grid();
    LAS unsigned char* lds = (LAS unsigned char*)lds_raw;
    const int tid = threadIdx.x, lane = tid & 63, wave = __builtin_amdgcn_readfirstlane(tid >> 6);
    const int G = gridDim.x, bx = blockIdx.x, vcu = (G % 8 == 0) ? (bx % 8) * (G / 8) + bx / 8 : bx;
    const int gw = vcu * 8 + wave, NGW = G * 8;
    volatile LAS unsigned* MISC = (volatile LAS unsigned*)(lds + 131072);
    if (tid < 32) MISC[tid] = 0u;
    __syncthreads();
    unsigned char* ws = args.ws;
    const float* x = args.in[0]; const float* norm_gains = args.in[1]; const float* sb_w_qkv = args.in[2]; const float* sb_q_gain = args.in[3]; const float* sb_k_gain = args.in[4];
    const float* sb_w_o = args.in[5]; const float* hg_w_in = args.in[6]; const float* hg_lb = args.in[7]; const float* hg_norm_gain = args.in[8]; const float* hg_w_o = args.in[9];
    const float* mlp_w1 = args.in[10]; const float* mlp_w2 = args.in[11];
    float* out = args.out;
    float* rowss = (float*)(ws + WS_ROWSS);
    bf16* XB = (bf16*)(ws + WS_XB);
    bf16* XH = (bf16*)(ws + WS_XH);
    bf16* BIG = (bf16*)(ws + WS_BIG);
    const size_t PLANE = (size_t)MTOK * DM;

    {
        LAS float* scr = (LAS float*)(lds + wave * 16384);
        constexpr int I_QKV = (DM / 64) * (3 * DM / 32), I_O = (DM / 64) * (DM / 32), I_IN = (DM / 64) * (4 * DM / 32), I_1 = (DM / 64) * (FF / 32), I_2 = (FF / 64) * (DM / 32);
        constexpr int NITEMS = 2 * I_QKV + 2 * I_O + 2 * I_IN + 2 * I_O + 4 * I_1 + 4 * I_2;
        for (int it = gw; it < NITEMS; it += NGW) {
            int r = it;
            if (r < 2 * I_QKV) { const int j = r / I_QKV; transpose_item<true, true>(sb_w_qkv + (size_t)j * DM * 3 * DM, DM, 3 * DM, norm_gains + (size_t)(2 * (2 * j)) * DM, (bf16*)(ws + W_SBQKV) + (size_t)j * 3 * DM * DM, scr, r % I_QKV, lane); continue; } r -= 2 * I_QKV;
            if (r < 2 * I_O) { const int j = r / I_O; transpose_item<false, false>(sb_w_o + (size_t)j * DM * DM, DM, DM, nullptr, (bf16*)(ws + W_SBO) + (size_t)j * DM * DM, scr, r % I_O, lane); continue; } r -= 2 * I_O;
            if (r < 2 * I_IN) { const int j = r / I_IN; transpose_item<false, true>(hg_w_in + (size_t)j * DM * 4 * DM, DM, 4 * DM, norm_gains + (size_t)(2 * (2 * j + 1)) * DM, (bf16*)(ws + W_HGIN) + (size_t)j * 4 * DM * DM, scr, r % I_IN, lane); continue; } r -= 2 * I_IN;
            if (r < 2 * I_O) { const int j = r / I_O; transpose_item<false, false>(hg_w_o + (size_t)j * DM * DM, DM, DM, nullptr, (bf16*)(ws + W_HGO) + (size_t)j * DM * DM, scr, r % I_O, lane); continue; } r -= 2 * I_O;
            if (r < 4 * I_1) { const int l = r / I_1; transpose_item<false, true>(mlp_w1 + (size_t)l * DM * FF, DM, FF, norm_gains + (size_t)(2 * l + 1) * DM, (bf16*)(ws + W_W1) + (size_t)l * FF * DM, scr, r % I_1, lane); continue; } r -= 4 * I_1;
            { const int l = r / I_2; transpose_item<false, false>(mlp_w2 + (size_t)l * FF * DM, FF, DM, nullptr, (bf16*)(ws + W_W2) + (size_t)l * DM * FF, scr, r % I_2, lane); }
        }
        for (int m = gw; m < MTOK; m += NGW) {
            const f32x4* xr = (const f32x4*)(x + (size_t)m * DM) + lane; float s = 0.f;
            unsigned long long* h8 = (unsigned long long*)(XH + (size_t)m * DM) + lane;
#pragma unroll
            for (int j = 0; j < 4; ++j) { const f32x4 v = xr[64 * j]; s += (v[0] * v[0] + v[1] * v[1]) + (v[2] * v[2] + v[3] * v[3]); h8[64 * j] = (unsigned long long)pg8::pk_h2(v[0], v[1]) | ((unsigned long long)pg8::pk_h2(v[2], v[3]) << 32); }
#pragma unroll
            for (int o = 1; o < 64; o <<= 1) s += __shfl_xor(s, o);
            if (lane == 0) rowss[m] = s;
        }
        for (int i = bx * 512 + tid; i < 8 * MTOK; i += G * 512) rowss[MTOK + i] = 0.f;
        if (bx == 0) for (int i = tid; i < XCD_BAR_WORDS; i += 512) ((unsigned*)(ws + WS_BAR))[i] = 0u;
    }
    grid.sync();
    const XcdBarrier xbar = xcd_barrier_post((unsigned*)(ws + WS_BAR), MISC + 8);
#define SEAM() xcd_barrier(xbar)

    for (int L = 0; L < DEPTH; ++L) {
        const int j = L >> 1;
        const bf16* mixA;
        const bf16* mixW;
        if ((L & 1) == 0) {
            bf16* Qb = BIG; bf16* Kb = BIG + PLANE; bf16* Vb = BIG + 2 * PLANE;
            { pg8::Gemm g{XH, (const bf16*)(ws + W_SBQKV) + (size_t)j * 3 * DM * DM, MTOK, 3 * DM, DM}; pg8::StaticOrder S; S.init(MTOK, 3 * DM, G, bx);
              pg8::EpiQKV E{Qb, PLANE, rowss + (size_t)(2 * L) * MTOK, sb_q_gain + j * 64, (long)(sb_k_gain - sb_q_gain)};
              pg8::gemm_phase<pg8::EpiQKV, pg8::StaticOrder, true, true, true>(lds, g, S, E);
 }
            SEAM();
            sba::phase(Qb, Kb, Vb, Qb, lds, vcu, G);
            mixA = Qb; mixW = (const bf16*)(ws + W_SBO) + (size_t)j * DM * DM;
        } else {
            bf16* Qh = BIG; bf16* LF = BIG + PLANE; bf16* Iv = BIG + 2 * PLANE; bf16* Gg = BIG + 3 * PLANE;
            { pg8::Gemm g{XH, (const bf16*)(ws + W_HGIN) + (size_t)j * 4 * DM * DM, MTOK, 4 * DM, DM}; pg8::StaticOrder S; S.init(MTOK, 4 * DM, G, bx);
              pg8::EpiHgIn E{Qh, PLANE, rowss + (size_t)(2 * L) * MTOK, hg_lb, j};
              pg8::gemm_phase<pg8::EpiHgIn, pg8::StaticOrder, true, true, true>(lds, g, S, E);
 }
            SEAM();
            bf16* SCG = (bf16*)out; float* CT = (float*)((unsigned char*)out + 32 * MiB);
            hgs::pre_phase(Qh, LF, SCG, CT, lds, vcu, G);
            SEAM();
            hgs::phase(Qh, LF, Iv, SCG, CT, XB, lds, vcu, G);
            SEAM();
            hgs::norm_phase(XB, Gg, hg_norm_gain + j * 128, Qh, gw, NGW, lane);
            mixA = Qh; mixW = (const bf16*)(ws + W_HGO) + (size_t)j * DM * DM;
        }
        SEAM();
        { pg8::Gemm g{mixA, mixW, MTOK, DM, DM}; pg8::StaticOrder S; S.init(MTOK, DM, G, bx);
          pg8::EpiRes<false> E{XH, rowss + (size_t)(2 * L + 1) * MTOK, nullptr};
          pg8::gemm_phase<pg8::EpiRes<false>, pg8::StaticOrder, true, true>(lds, g, S, E);
 }
        SEAM();
        { pg8::Gemm g{XH, (const bf16*)(ws + W_W1) + (size_t)L * FF * DM, MTOK, FF, DM}; pg8::StaticOrder S; S.init(MTOK, FF, G, bx);
          pg8::EpiUp E{BIG, rowss + (size_t)(2 * L + 1) * MTOK};
          pg8::gemm_phase<pg8::EpiUp, pg8::StaticOrder, true, true, true>(lds, g, S, E);
 }
        SEAM();
        { pg8::Gemm g{BIG, (const bf16*)(ws + W_W2) + (size_t)L * DM * FF, MTOK, DM, FF}; pg8::StaticOrder S; S.init(MTOK, DM, G, bx, 1);
          if (L + 1 < DEPTH) { pg8::EpiRes<false> E{XH, rowss + (size_t)(2 * L + 2) * MTOK, nullptr}; pg8::gemm_phase<pg8::EpiRes<false>, pg8::StaticOrder, true, true>(lds, g, S, E); }
          else { pg8::EpiRes<true> E{XH, nullptr, out}; pg8::gemm_phase<pg8::EpiRes<true>, pg8::StaticOrder, true, true>(lds, g, S, E); }
 }
        if (L + 1 < DEPTH) SEAM();
    }
}

extern "C" void kernel_launch(void* const* d_in, const int* in_sizes, int n_in, void* d_out, int out_size, void* d_ws, size_t ws_size, hipStream_t stream) {
    static int grid = 0;
    if (grid == 0) {
        if (n_in != 12 || in_sizes[0] != MTOK * DM || out_size != MTOK * DM || ws_size < WS_END) { fprintf(stderr, "kernel_launch: unexpected shapes / workspace (n_in %d, ws %zu, need %zu)\n", n_in, ws_size, (size_t)WS_END); grid = -1; return; }
        int dev = 0, cus = 0, per_cu = 0;
        hipGetDevice(&dev); hipDeviceGetAttribute(&cus, hipDeviceAttributeMultiprocessorCount, dev);
        if (hipFuncSetAttribute((const void*)trunk_fwd, hipFuncAttributeMaxDynamicSharedMemorySize, LDS_BYTES) != hipSuccess) { fprintf(stderr, "kernel_launch: hipFuncSetAttribute failed\n"); grid = -1; return; }
        if (hipOccupancyMaxActiveBlocksPerMultiprocessor(&per_cu, (const void*)trunk_fwd, 512, LDS_BYTES) != hipSuccess || per_cu < 1) { fprintf(stderr, "kernel_launch: occupancy query says %d\n", per_cu); per_cu = 1; }
        (void)hipGetLastError();
        grid = cus * per_cu;
    }
    if (grid < 0) return;
    Args a{};
    for (int i = 0; i < 12; ++i) a.in[i] = (const float*)d_in[i];
    a.out = (float*)d_out; a.ws = (unsigned char*)d_ws;
    void* kargs[] = {&a};
    hipError_t e = hipLaunchCooperativeKernel((const void*)trunk_fwd, dim3(grid), dim3(512), kargs, LDS_BYTES, stream);
    if (e != hipSuccess) fprintf(stderr, "cooperative launch failed: %s (grid %d)\n", hipGetErrorString(e), grid);
}
```
